# Optimizing an MI355X kernel written in HIP

```python
import math
import jax
import jax.numpy as jnp
from jax import lax
import numpy as np

D_MODEL = 1024
BATCH = 8
SEQ = 2048
DEPTH = 2

CHUNK = 64
D_FF = 4096
LN_EPS = 1e-5
NORM_EPS = 1e-6
H_A = 4
DK_A = 128
DV_A = 128
CONV_K = 4
A_QK = H_A * DK_A
A_V = H_A * DV_A
H_B = 4
D_B = 128
B_PREV = 8
REL_CLIP = 128
B_W = H_B * D_B
H_C = 8
HKV_C = 2
G_C = H_C // HKV_C
D_C = 64
WINDOW = 128
C_PREV = WINDOW // CHUNK
C_Q = H_C * D_C
C_KV = HKV_C * D_C
N_BRANCH = 3
IN_SPLITS = (A_QK, A_QK, A_V, H_A, H_A, A_V, B_W, B_W, B_W, C_Q, C_KV, C_KV)
D_IN = sum(IN_SPLITS)

kernel_name = 'hybrid_chunk_streaming_block'


def layer_norm(x, g, b):
    xf = x.astype(jnp.float32)
    mu = jnp.mean(xf, -1, keepdims=True)
    xc = xf - mu
    var = jnp.mean(xc * xc, -1, keepdims=True)
    return (xc * lax.rsqrt(var + LN_EPS) * g.astype(jnp.float32) + b.astype(jnp.float32)).astype(x.dtype)


def swiglu(x, w_in, w_out):
    gate, up = jnp.split(x @ w_in, 2, axis=-1)
    return (jax.nn.silu(gate) * up) @ w_out


def causal_depthwise_conv(x, w):
    k = w.shape[0]
    return lax.conv_general_dilated(x, w[:, None, :], window_strides=(1,), padding=[(k - 1, 0)],
                                    dimension_numbers=('NWC', 'WIO', 'NWC'),
                                    feature_group_count=x.shape[-1])


def l2_normalize(x):
    return x * lax.rsqrt(jnp.sum(x * x, -1, keepdims=True) + NORM_EPS)


def to_chunks(a):
    b, t, h = a.shape[:3]
    a = a.reshape(b, t // CHUNK, CHUNK, h, *a.shape[3:])
    return jnp.moveaxis(a, (1, 3), (0, 2))


def chunk_gated_delta_rule(q, k, v, g, beta):
    b, t, h, dk = q.shape
    dv = v.shape[-1]
    q = to_chunks(q) * (dk ** -0.5)
    k = to_chunks(k)
    v = to_chunks(v)
    g = to_chunks(g)
    beta = to_chunks(beta)
    g_cum = jnp.cumsum(g, axis=-1)
    idx = jnp.arange(CHUNK)
    causal = idx[:, None] >= idx[None, :]
    strict = idx[:, None] > idx[None, :]
    decay = jnp.exp(jnp.where(causal, g_cum[..., :, None] - g_cum[..., None, :], -jnp.inf))
    k_beta = k * beta[..., None]
    lower = jnp.where(strict, jnp.einsum('nbhid,nbhjd->nbhij', k_beta, k) * decay, 0.0)
    eye = jnp.eye(CHUNK, dtype=jnp.float32)
    rhs = jnp.concatenate([v * beta[..., None], k_beta * jnp.exp(g_cum)[..., None]], axis=-1)
    uw = lax.linalg.triangular_solve(eye + lower, rhs, left_side=True, lower=True, unit_diagonal=True)
    u, w = uw[..., :dv], uw[..., dv:]
    attn = jnp.einsum('nbhid,nbhjd->nbhij', q, k) * decay
    q_dec = q * jnp.exp(g_cum)[..., None]
    g_last = g_cum[..., -1]
    k_dec = k * jnp.exp(g_last[..., None] - g_cum)[..., None]

    def step(state, inp):
        q_c, k_c, u_c, w_c, a_c, gl_c = inp
        v_new = u_c - jnp.einsum('bhcd,bhdv->bhcv', w_c, state)
        o_c = jnp.einsum('bhcd,bhdv->bhcv', q_c, state) + jnp.einsum('bhij,bhjv->bhiv', a_c, v_new)
        state = state * jnp.exp(gl_c)[..., None, None] + jnp.einsum('bhcd,bhcv->bhdv', k_c, v_new)
        return state, o_c

    s0 = jnp.zeros((b, h, dk, dv), jnp.float32)
    _, o = lax.scan(step, s0, (q_dec, k_dec, u, w, attn, g_last))
    o = jnp.moveaxis(o, (0, 2), (1, 3))
    return o.reshape(b, t, h, dv)


def gated_deltanet(qa, ka, va, beta_raw, a_raw, za, conv_w, a_log, dt_bias, norm_g):
    b, t, _ = qa.shape
    f32 = jnp.float32
    qkv = jax.nn.silu(causal_depthwise_conv(jnp.concatenate([qa, ka, va], -1), conv_w)).astype(f32)
    q, k, v = jnp.split(qkv, [A_QK, 2 * A_QK], axis=-1)
    q = l2_normalize(q.reshape(b, t, H_A, DK_A))
    k = l2_normalize(k.reshape(b, t, H_A, DK_A))
    v = v.reshape(b, t, H_A, DV_A)
    beta = jax.nn.sigmoid(beta_raw.astype(f32))
    g = -jnp.exp(a_log.astype(f32)) * jax.nn.softplus(a_raw.astype(f32) + dt_bias.astype(f32))
    o = chunk_gated_delta_rule(q, k, v, g, beta)
    z = za.reshape(b, t, H_A, DV_A).astype(f32)
    o = o * lax.rsqrt(jnp.mean(o * o, -1, keepdims=True) + NORM_EPS) * norm_g.astype(f32) * jax.nn.silu(z)
    return o.reshape(b, t, A_V).astype(qa.dtype)


def chunk_band(a, n_prev):
    b, t = a.shape[:2]
    n = t // CHUNK
    pad = [(0, 0), (n_prev * CHUNK, 0)] + [(0, 0)] * (a.ndim - 2)
    ap = jnp.pad(a, pad).reshape(b, n + n_prev, CHUNK, *a.shape[2:])
    band = jnp.stack([ap[:, j:j + n] for j in range(n_prev + 1)], axis=2)
    return band.reshape(b, n, (n_prev + 1) * CHUNK, *a.shape[2:])


def band_geometry(n, n_prev):
    i = jnp.arange(CHUNK)
    j = jnp.arange((n_prev + 1) * CHUNK)
    dist = n_prev * CHUNK + i[:, None] - j[None, :]
    valid = (jnp.arange(n)[:, None] - n_prev + j[None, :] // CHUNK) >= 0
    return dist, valid


def alibi_slopes(n):
    return 2.0 ** (-8.0 * jnp.arange(1, n + 1, dtype=jnp.float32) / n)


def chunk_relpos_attention(q, k, v, rel_bias):
    b, t, _ = q.shape
    n = t // CHUNK
    q = q.reshape(b, n, CHUNK, H_B, D_B)
    kb = chunk_band(k.reshape(b, t, H_B, D_B), B_PREV)
    vb = chunk_band(v.reshape(b, t, H_B, D_B), B_PREV)
    s = jnp.einsum('bnqhd,bnkhd->bnhqk', q, kb).astype(jnp.float32) * (D_B ** -0.5)
    dist, valid = band_geometry(n, B_PREV)
    rel_idx = jnp.clip(dist, -(CHUNK - 1), REL_CLIP) + (CHUNK - 1)
    bias = rel_bias.astype(jnp.float32)[:, rel_idx]
    s = jnp.where(valid[None, :, None, None, :], s + bias, -jnp.inf)
    p = jax.nn.softmax(s, axis=-1).astype(v.dtype)
    o = jnp.einsum('bnhqk,bnkhd->bnqhd', p, vb)
    return o.reshape(b, t, B_W)


def swa_sink_attention(q, k, v, sinks):
    b, t, _ = q.shape
    n = t // CHUNK
    q = q.reshape(b, n, CHUNK, HKV_C, G_C, D_C)
    kb = chunk_band(k.reshape(b, t, HKV_C, D_C), C_PREV)
    vb = chunk_band(v.reshape(b, t, HKV_C, D_C), C_PREV)
    s = jnp.einsum('bnqhgd,bnkhd->bnhgqk', q, kb).astype(jnp.float32) * (D_C ** -0.5)
    dist, valid = band_geometry(n, C_PREV)
    slopes = alibi_slopes(H_C).reshape(HKV_C, G_C)
    s = s - slopes[:, :, None, None] * jnp.abs(dist).astype(jnp.float32)
    s = jnp.where(valid[None, :, None, None, None, :], s, -jnp.inf)
    sink = jnp.broadcast_to(sinks.astype(jnp.float32).reshape(HKV_C, G_C)[:, :, None, None], s.shape[:-1] + (1,))
    p = jax.nn.softmax(jnp.concatenate([s, sink], axis=-1), axis=-1)[..., :-1].astype(v.dtype)
    o = jnp.einsum('bnhgqk,bnkhd->bnqhgd', p, vb)
    return o.reshape(b, t, C_Q)


def hybrid_mixer(x, w_in, b_in, conv_w, a_log, dt_bias, gdn_norm_g, rel_bias, sinks,
                 w_gate, b_gate, w_br_a, w_br_b, w_br_c, w_out):
    b, t, d = x.shape
    proj = x @ w_in + b_in
    split_at = np.cumsum(IN_SPLITS)[:-1].tolist()
    (qa, ka, va, beta_raw, a_raw, za, qb, kb, vb, qc, kc, vc) = jnp.split(proj, split_at, axis=-1)
    o_a = gated_deltanet(qa, ka, va, beta_raw, a_raw, za, conv_w, a_log, dt_bias, gdn_norm_g)
    o_b = chunk_relpos_attention(qb, kb, vb, rel_bias)
    o_c = swa_sink_attention(qc, kc, vc, sinks)
    gates = jax.nn.sigmoid(x @ w_gate + b_gate).reshape(b, t, N_BRANCH, d)
    merged = (gates[:, :, 0] * (o_a @ w_br_a) + gates[:, :, 1] * (o_b @ w_br_b)
              + gates[:, :, 2] * (o_c @ w_br_c))
    return merged @ w_out


def setup_inputs(seed: int = 0) -> dict:
    key = jax.random.key(seed)
    keys = list(jax.random.split(key, 32))
    f32 = jnp.float32
    L, D = DEPTH, D_MODEL
    sub_scale = (8.0 * DEPTH) ** -0.25

    def nrm(shape, scale):
        return jax.random.normal(keys.pop(), shape, f32) * scale

    def gain(shape):
        return 1.0 + nrm(shape, 0.02)

    x = nrm((BATCH, SEQ, D), 1.0)
    ln1_g = gain((L, D))
    ln1_b = nrm((L, D), 0.02)
    w_ff1_in = nrm((L, D, 2 * D_FF), D ** -0.5)
    w_ff1_out = nrm((L, D_FF, D), D_FF ** -0.5 * sub_scale)
    w_in = nrm((L, D, D_IN), D ** -0.5)
    b_in = nrm((L, D_IN), 0.02)
    conv_w = nrm((L, CONV_K, 2 * A_QK + A_V), CONV_K ** -0.5)
    a_log = jnp.log(jax.random.uniform(keys.pop(), (L, H_A), f32, 1.0, 16.0))
    dt = jnp.exp(jax.random.uniform(keys.pop(), (L, H_A), f32, math.log(1e-3), math.log(1e-1)))
    dt_bias = dt + jnp.log(-jnp.expm1(-dt))
    gdn_norm_g = gain((L, DV_A))
    rel_bias = nrm((L, H_B, CHUNK + REL_CLIP), 0.1)
    sinks = nrm((L, H_C), 0.5)
    w_gate = nrm((L, D, N_BRANCH * D), D ** -0.5)
    b_gate = nrm((L, N_BRANCH * D), 0.02)
    w_br_a = nrm((L, A_V, D), A_V ** -0.5 * sub_scale)
    w_br_b = nrm((L, B_W, D), B_W ** -0.5 * sub_scale)
    w_br_c = nrm((L, C_Q, D), C_Q ** -0.5 * sub_scale)
    w_out = nrm((L, D, D), D ** -0.5 * sub_scale)
    ln2_g = gain((L, D))
    ln2_b = nrm((L, D), 0.02)
    w_ff2_in = nrm((L, D, 2 * D_FF), D ** -0.5)
    w_ff2_out = nrm((L, D_FF, D), D_FF ** -0.5 * sub_scale)
    ln3_g = gain((L, D))
    ln3_b = nrm((L, D), 0.02)
    return {'x': x, 'ln1_g': ln1_g, 'ln1_b': ln1_b, 'w_ff1_in': w_ff1_in, 'w_ff1_out': w_ff1_out,
            'w_in': w_in, 'b_in': b_in, 'conv_w': conv_w, 'a_log': a_log, 'dt_bias': dt_bias,
            'gdn_norm_g': gdn_norm_g, 'rel_bias': rel_bias, 'sinks': sinks, 'w_gate': w_gate,
            'b_gate': b_gate, 'w_br_a': w_br_a, 'w_br_b': w_br_b, 'w_br_c': w_br_c, 'w_out': w_out,
            'ln2_g': ln2_g, 'ln2_b': ln2_b, 'w_ff2_in': w_ff2_in, 'w_ff2_out': w_ff2_out,
            'ln3_g': ln3_g, 'ln3_b': ln3_b}


def reference(x, ln1_g, ln1_b, w_ff1_in, w_ff1_out, w_in, b_in, conv_w, a_log, dt_bias,
              gdn_norm_g, rel_bias, sinks, w_gate, b_gate, w_br_a, w_br_b, w_br_c, w_out,
              ln2_g, ln2_b, w_ff2_in, w_ff2_out, ln3_g, ln3_b):
    alpha = (2.0 * DEPTH) ** 0.25
    for l in range(DEPTH):
        x = layer_norm(alpha * x + 0.5 * swiglu(x, w_ff1_in[l], w_ff1_out[l]), ln1_g[l], ln1_b[l])
        mix = hybrid_mixer(x, w_in[l], b_in[l], conv_w[l], a_log[l], dt_bias[l], gdn_norm_g[l],
                           rel_bias[l], sinks[l], w_gate[l], b_gate[l], w_br_a[l], w_br_b[l],
                           w_br_c[l], w_out[l])
        x = layer_norm(alpha * x + mix, ln2_g[l], ln2_b[l])
        x = layer_norm(alpha * x + 0.5 * swiglu(x, w_ff2_in[l], w_ff2_out[l]), ln3_g[l], ln3_b[l])
    return x
```

```cpp
#include <hip/hip_runtime.h>
#include <hip/hip_cooperative_groups.h>
#include <cstdio>
namespace cg = cooperative_groups;

#define LAS __attribute__((address_space(3)))
typedef unsigned short bf16_t;
typedef short bf16x8 __attribute__((ext_vector_type(8)));
typedef float f32x4 __attribute__((ext_vector_type(4)));
typedef float f32x2 __attribute__((ext_vector_type(2)));
typedef unsigned u32x4 __attribute__((ext_vector_type(4)));
typedef unsigned u32x2 __attribute__((ext_vector_type(2)));

constexpr int M_TOK = 16384, DM = 1024, DFF = 4096, SEQ = 2048, NCHUNK = 32;
constexpr int PROJ_LD = 4352;
constexpr int C_QA = 0, C_KA = 512, C_VA = 1024, C_ZA = 1536, C_QB = 2048, C_KB = 2560, C_VB = 3072, C_QC = 3584, C_KC = 4096, C_VC = 4224;
constexpr int WIN_LD = 4360;
constexpr size_t MiB = 1ull << 20;
constexpr size_t WS_SLOTA = 0, WS_SLOTB = 16 * MiB, WS_XB = 32 * MiB, WS_R = 64 * MiB;
constexpr size_t WS_H = WS_R, WS_YFFN = WS_R + 128 * MiB;
constexpr size_t WS_PROJ = WS_R, WS_YMIX = WS_R;
constexpr size_t WS_R2 = WS_R + 136 * MiB;
constexpr size_t WS_QN = WS_R2, WS_KN = WS_R2 + 16 * MiB, WS_VC = WS_R2 + 32 * MiB;
constexpr size_t WS_GATES = WS_R2;
constexpr size_t WS_MERGED = WS_R2 + 96 * MiB;
constexpr size_t WS_BETA = WS_R2 + 128 * MiB, WS_GLOG = WS_BETA + 256 * 1024;
constexpr size_t WS_END = WS_GLOG + 256 * 1024;
constexpr size_t SB_WGATE = 0, SB_WBR = 6 * MiB, SB_WOUT = 9 * MiB;

typedef __bf16 bf16x2_n __attribute__((ext_vector_type(2)));
__device__ __forceinline__ unsigned cvt_pk_bf16(float lo, float hi) { const f32x2 v = {lo, hi}; const bf16x2_n b = __builtin_convertvector(v, bf16x2_n); return __builtin_bit_cast(unsigned, b); }
__device__ __forceinline__ float bf_lo(unsigned w) { return __uint_as_float(w << 16); }
__device__ __forceinline__ float bf_hi(unsigned w) { return __uint_as_float(w & 0xffff0000u); }
__device__ __forceinline__ float bf2f(bf16_t b) { return __uint_as_float(((unsigned)b) << 16); }
__device__ __forceinline__ float fast_sigmoid(float x) { return __builtin_amdgcn_rcpf(1.0f + __expf(-x)); }
__device__ __forceinline__ float fast_silu(float x) { return x * fast_sigmoid(x); }

namespace pg8 {
constexpr int BM = 256, BK = 64, HALF = 128, HTB = HALF * BK * 2  , STAGE_BYTES = 8 * HTB, NXCD = 8, WGM = 8;

__host__ __device__ __forceinline__ int lds_byte(int r, int c) { const int st = (r >> 4) * 2 + (c >> 5), rr = r & 15, cc = c & 31, ob = rr * 64 + cc * 2; return st * 1024 + (ob ^ (((ob >> 9) & 1) << 5)); }
__host__ __device__ __forceinline__ void stage_rc(int b, int& R, int& C) { const int st = b / 1024, sb = b % 1024, swz = sb ^ (((sb >> 9) & 1) << 5); R = (st >> 1) * 16 + swz / 64; C = (st & 1) * 32 + (swz % 64) / 2; }
__host__ __device__ __forceinline__ int perm32(int rho) { const int n = rho >> 4, i = rho & 15; return 8 * (i >> 2) + 4 * n + (i & 3); }

struct Unit { int pm, pn; };
struct Gemm { const bf16_t* A; const bf16_t* Bt; int M, N, K, lda, ldb; };

__device__ __forceinline__ void remap_tile(int wgid, int nM, int nN, int& pm, int& pn) {
    const int nwg = nM * nN;
    { const int q = nwg / NXCD, r = nwg % NXCD, xcd = wgid % NXCD, off = wgid / NXCD; wgid = (xcd < r ? xcd * (q + 1) : r * (q + 1) + (xcd - r) * q) + off; }
    const int nig = WGM * nN, gid = wgid / nig, fm = gid * WGM, gsz = (nM - fm) < WGM ? (nM - fm) : WGM;
    pm = fm + ((wgid % nig) % gsz); pn = (wgid % nig) / gsz;
}
struct StaticOrder {
    int nM, nN, nwg, G, c;
    __device__ void init(int M, int N, int G_, int c_) { nM = M / BM; nN = N / BM; nwg = nM * nN; G = G_; c = c_; }
    __device__ bool next(int i, Unit& u) const {
        const long L = (long)i * G + c; if (L >= nwg) return false;
        remap_tile((int)L, nM, nN, u.pm, u.pn); return true;
    }
    __device__ __forceinline__ int a_coloff(const Unit&) const { return 0; }
};
struct BranchOrder {
    int G, c;
    __device__ bool next(int i, Unit& u) const {
        const int ti = i / 3, br = i - 3 * ti; const long L = (long)ti * G + c; if (L >= 256) return false;
        int pm, pn4; remap_tile((int)L, 64, 4, pm, pn4); u.pm = pm; u.pn = br * 4 + pn4; return true;
    }
    __device__ __forceinline__ int a_coloff(const Unit& u) const { const int br = u.pn >> 2; return br == 0 ? C_QA : (br == 1 ? C_QB : C_QC); }
};

template <class Epi, class Sched>
__device__ __forceinline__ void gemm_phase(LAS unsigned char* lds, const Gemm g, const Sched& S, const Epi& E) {
    int tid_ = threadIdx.x; asm volatile("" : "+v"(tid_));
    const int tid = tid_, wid = __builtin_amdgcn_readfirstlane(tid >> 6), lane = tid & 63, wr = wid >> 2, wc = wid & 3, fr = lane & 15, fq = lane >> 4;
    const int K = g.K, nt = K / BK;
    unsigned voffA[2], voffB[2];
#pragma unroll
    for (int i = 0; i < 2; ++i) { int R, C; stage_rc(tid * 16 + i * 8192, R, C); const int Rb = Epi::PERM ? ((R & ~31) + perm32(R & 31)) : R;
        voffA[i] = (unsigned)(R * g.lda + C) * 2u; voffB[i] = (unsigned)(Rb * g.ldb + C) * 2u; }
    const size_t kstep = (size_t)(BK * 2);
    const size_t hstepA = (size_t)HALF * g.lda * 2, hstepB = (size_t)HALF * g.ldb * 2;
    const size_t tstepA = 2 * hstepA, tstepB = 2 * hstepB;
    const unsigned ldsw = (unsigned)wid * 1024u;
    const int aoff = lds_byte(wr * 64 + fr, fq * 8), boff = lds_byte(wc * 32 + fr, fq * 8);
#define PG8_SA(b, h) (((b) * 2 + (h)) * HTB)
#define PG8_SB(b, h) ((4 + (b) * 2 + (h)) * HTB)
#define PG8_STAGE(bufoff, gbase, voff) do { _Pragma("unroll") for (int _i = 0; _i < 2; ++_i) \
        __builtin_amdgcn_global_load_lds((const unsigned*)((const char*)(gbase) + (voff)[_i]), (LAS unsigned*)(lds + (bufoff) + ldsw + _i * 8192), 16, 0, 0); } while (0)
#define PG8_LDA(dst, b, h) do { _Pragma("unroll") for (int m = 0; m < 4; ++m) _Pragma("unroll") for (int k = 0; k < 2; ++k) dst[m][k] = *(const LAS bf16x8*)(lds + PG8_SA(b, h) + aoff + m * 2048 + k * 1024); } while (0)
#define PG8_LDB(dst, b, h) do { _Pragma("unroll") for (int n = 0; n < 2; ++n) _Pragma("unroll") for (int k = 0; k < 2; ++k) dst[n][k] = *(const LAS bf16x8*)(lds + PG8_SB(b, h) + boff + n * 2048 + k * 1024); } while (0)
#define PG8_MMA(ai, bj, At, Bt) do { __builtin_amdgcn_s_setprio(1); _Pragma("unroll") for (int m = 0; m < 4; ++m) _Pragma("unroll") for (int n = 0; n < 2; ++n) _Pragma("unroll") for (int k = 0; k < 2; ++k) \
        acc[ai][bj][m][n] = __builtin_amdgcn_mfma_f32_16x16x32_bf16(Bt[n][k], At[m][k], acc[ai][bj][m][n], 0, 0, 0); __builtin_amdgcn_s_setprio(0); } while (0)
#define PG8_WAIT_V(n) asm volatile("s_waitcnt vmcnt(" #n ")" ::: "memory")
#define PG8_WAIT_L(n) asm volatile("s_waitcnt lgkmcnt(" #n ")" ::: "memory")
#define PG8_BAR __builtin_amdgcn_s_barrier()
#define PG8_SCHED __builtin_amdgcn_sched_barrier(0)
    Unit cur, nxt; int ui = 0;
    if (!S.next(0, cur)) return;
    f32x4 acc[2][2][4][2];
#pragma unroll
    for (int a = 0; a < 2; ++a)
#pragma unroll
        for (int b = 0; b < 2; ++b)
#pragma unroll
            for (int m = 0; m < 4; ++m)
#pragma unroll
                for (int n = 0; n < 2; ++n) acc[a][b][m][n] = (f32x4){0.f, 0.f, 0.f, 0.f};
    bf16x8 At[4][2], B0[2][2], B1[2][2];
    const char* cA = (const char*)g.A + (size_t)cur.pm * tstepA + (size_t)S.a_coloff(cur) * 2; const char* cB = (const char*)g.Bt + (size_t)cur.pn * tstepB;
    PG8_STAGE(PG8_SB(0, 0), cB, voffB); PG8_STAGE(PG8_SA(0, 0), cA, voffA); PG8_STAGE(PG8_SB(0, 1), cB + hstepB, voffB); PG8_STAGE(PG8_SA(0, 1), cA + hstepA, voffA);
    if (wr == 1) PG8_BAR;
    PG8_WAIT_V(4); PG8_BAR;
    PG8_STAGE(PG8_SB(1, 0), cB + kstep, voffB); PG8_STAGE(PG8_SA(1, 0), cA + kstep, voffA); PG8_STAGE(PG8_SB(1, 1), cB + hstepB + kstep, voffB);
    PG8_WAIT_V(6); PG8_BAR;
    for (;;) {
        const bool has_next = S.next(ui + 1, nxt);
        const char* nA = has_next ? (const char*)g.A + (size_t)nxt.pm * tstepA + (size_t)S.a_coloff(nxt) * 2 : cA; const char* nB = has_next ? (const char*)g.Bt + (size_t)nxt.pn * tstepB : cB;
        for (int t = 0; t < nt; t += 2) {
            const bool last = (t == nt - 2);
            const char* a1 = cA + (size_t)(t + 1) * kstep;
            const char* a2 = last ? nA : cA + (size_t)(t + 2) * kstep; const char* b2 = last ? nB : cB + (size_t)(t + 2) * kstep;
            const char* a3 = a2 + kstep; const char* b3 = b2 + kstep;
            PG8_LDB(B0, 0, 0); PG8_SCHED; PG8_LDA(At, 0, 0); PG8_STAGE(PG8_SA(1, 1), a1 + hstepA, voffA);
            PG8_WAIT_L(8); PG8_BAR; PG8_WAIT_L(0); PG8_MMA(0, 0, At, B0); PG8_BAR; PG8_SCHED;
            PG8_LDB(B1, 0, 1); PG8_STAGE(PG8_SB(0, 0), b2, voffB);
            PG8_BAR; PG8_WAIT_L(0); PG8_MMA(0, 1, At, B1); PG8_BAR;
            PG8_LDA(At, 0, 1); PG8_STAGE(PG8_SA(0, 0), a2, voffA);
            PG8_BAR; PG8_WAIT_L(0); PG8_MMA(1, 0, At, B0); PG8_BAR; PG8_SCHED;
            PG8_STAGE(PG8_SB(0, 1), b2 + hstepB, voffB);
            PG8_WAIT_V(6); PG8_BAR; PG8_MMA(1, 1, At, B1); PG8_BAR;
            PG8_LDB(B0, 1, 0); PG8_SCHED; PG8_LDA(At, 1, 0); PG8_STAGE(PG8_SA(0, 1), a2 + hstepA, voffA);
            PG8_WAIT_L(8); PG8_BAR; PG8_WAIT_L(0); PG8_MMA(0, 0, At, B0); PG8_BAR; PG8_SCHED;
            PG8_LDB(B1, 1, 1); PG8_STAGE(PG8_SB(1, 0), b3, voffB);
            PG8_BAR; PG8_WAIT_L(0); PG8_MMA(0, 1, At, B1); PG8_BAR;
            PG8_LDA(At, 1, 1); PG8_STAGE(PG8_SA(1, 0), a3, voffA);
            PG8_BAR; PG8_WAIT_L(0); PG8_MMA(1, 0, At, B0); PG8_BAR; PG8_SCHED;
            PG8_STAGE(PG8_SB(1, 1), b3 + hstepB, voffB);
            PG8_WAIT_V(6); PG8_BAR; PG8_MMA(1, 1, At, B1); PG8_BAR;
        }
        E(acc, cur, wr, wc, fr, fq);
        if (!has_next) break;
#pragma unroll
        for (int a = 0; a < 2; ++a)
#pragma unroll
            for (int b = 0; b < 2; ++b)
#pragma unroll
                for (int m = 0; m < 4; ++m)
#pragma unroll
                    for (int n = 0; n < 2; ++n) acc[a][b][m][n] = (f32x4){0.f, 0.f, 0.f, 0.f};
        cur = nxt; cA = nA; cB = nB; ++ui;
    }
    PG8_WAIT_V(0);
    if (wr == 0) PG8_BAR;
    PG8_BAR;
#undef PG8_SA
#undef PG8_SB
#undef PG8_STAGE
#undef PG8_LDA
#undef PG8_LDB
#undef PG8_MMA
#undef PG8_WAIT_V
#undef PG8_WAIT_L
#undef PG8_BAR
#undef PG8_SCHED
}

struct EpiSwiGLU {
    static constexpr bool PERM = true;
    bf16_t* H;
    __device__ __forceinline__ void operator()(const f32x4 (&acc)[2][2][4][2], const Unit& u, int wr, int wc, int fr, int fq) const {
        const int row0 = u.pm * BM + wr * 64 + fr, col0 = u.pn * 128 + wc * 32 + 8 * fq;
#pragma unroll
        for (int ai = 0; ai < 2; ++ai)
#pragma unroll
            for (int m = 0; m < 4; ++m) {
                bf16_t* rowp = H + (size_t)(row0 + ai * HALF + m * 16) * DFF + col0;
                const f32x4 g0 = acc[ai][0][m][0], g1 = acc[ai][0][m][1], u0 = acc[ai][1][m][0], u1 = acc[ai][1][m][1];
                float v[8];
#pragma unroll
                for (int j = 0; j < 4; ++j) { v[j] = fast_silu(g0[j]) * u0[j]; v[4 + j] = fast_silu(g1[j]) * u1[j]; }
                u32x4 w; w.x = cvt_pk_bf16(v[0], v[1]); w.y = cvt_pk_bf16(v[2], v[3]); w.z = cvt_pk_bf16(v[4], v[5]); w.w = cvt_pk_bf16(v[6], v[7]);
                *(u32x4*)rowp = w;
            }
    }
};
struct EpiResid {
    static constexpr bool PERM = false;
    const float* res; float* Y; float alpha, s;
    __device__ __forceinline__ void operator()(const f32x4 (&acc)[2][2][4][2], const Unit& u, int wr, int wc, int fr, int fq) const {
        const int row0 = u.pm * BM + wr * 64 + fr, col0 = u.pn * BM + wc * 32 + 4 * fq;
#pragma unroll
        for (int ai = 0; ai < 2; ++ai)
#pragma unroll
            for (int m = 0; m < 4; ++m) { const size_t off = (size_t)(row0 + ai * HALF + m * 16) * DM + col0;
#pragma unroll
                for (int bj = 0; bj < 2; ++bj)
#pragma unroll
                    for (int n = 0; n < 2; ++n) { const f32x4 r = *(const f32x4*)(res + off + bj * HALF + n * 16); *(f32x4*)(Y + off + bj * HALF + n * 16) = r * alpha + acc[ai][bj][m][n] * s; }
                asm volatile("" ::: "memory"); }
    }
};
template <int ACT  , int SHIFT_AT  > struct EpiBiasBf16 {
    static constexpr bool PERM = true;
    bf16_t* O; int ldc; const float* bias;
    __device__ __forceinline__ void operator()(const f32x4 (&acc)[2][2][4][2], const Unit& u, int wr, int wc, int fr, int fq) const {
        const int row0 = u.pm * BM + wr * 64 + fr, col0 = u.pn * BM + wc * 32 + 8 * fq;
        f32x4 bv[2][2];
#pragma unroll
        for (int bj = 0; bj < 2; ++bj) { const int c = col0 + bj * HALF; const int bc = c + (c >= SHIFT_AT ? 8 : 0);
            bv[bj][0] = *(const f32x4*)(bias + bc); bv[bj][1] = *(const f32x4*)(bias + bc + 4); }
#pragma unroll
        for (int ai = 0; ai < 2; ++ai)
#pragma unroll
            for (int m = 0; m < 4; ++m) { bf16_t* rowp = O + (size_t)(row0 + ai * HALF + m * 16) * ldc + col0;
#pragma unroll
                for (int bj = 0; bj < 2; ++bj) { f32x4 v0 = acc[ai][bj][m][0] + bv[bj][0], v1 = acc[ai][bj][m][1] + bv[bj][1];
                    if (ACT == 1) {
#pragma unroll
                        for (int j = 0; j < 4; ++j) { v0[j] = fast_sigmoid(v0[j]); v1[j] = fast_sigmoid(v1[j]); } }
                    u32x4 w; w.x = cvt_pk_bf16(v0[0], v0[1]); w.y = cvt_pk_bf16(v0[2], v0[3]); w.z = cvt_pk_bf16(v1[0], v1[1]); w.w = cvt_pk_bf16(v1[2], v1[3]);
                    *(u32x4*)(rowp + bj * HALF) = w; } }
    }
};
struct EpiBranch {
    static constexpr bool PERM = true;
    const bf16_t* gates; bf16_t* MG;
    __device__ __forceinline__ void operator()(const f32x4 (&acc)[2][2][4][2], const Unit& u, int wr, int wc, int fr, int fq) const {
        const int br = u.pn >> 2, pn4 = u.pn & 3;
        const int row0 = u.pm * BM + wr * 64 + fr, col0 = pn4 * BM + wc * 32 + 8 * fq;
#pragma unroll
        for (int ai = 0; ai < 2; ++ai)
#pragma unroll
            for (int m = 0; m < 4; ++m) { const size_t r = (size_t)(row0 + ai * HALF + m * 16);
#pragma unroll
                for (int bj = 0; bj < 2; ++bj) { const int c = col0 + bj * HALF;
                    const u32x4 gw = *(const u32x4*)(gates + r * 3072 + br * 1024 + c);
                    const f32x4 a0 = acc[ai][bj][m][0], a1 = acc[ai][bj][m][1];
                    float v[8];
                    v[0] = bf_lo(gw.x) * a0[0]; v[1] = bf_hi(gw.x) * a0[1]; v[2] = bf_lo(gw.y) * a0[2]; v[3] = bf_hi(gw.y) * a0[3];
                    v[4] = bf_lo(gw.z) * a1[0]; v[5] = bf_hi(gw.z) * a1[1]; v[6] = bf_lo(gw.w) * a1[2]; v[7] = bf_hi(gw.w) * a1[3];
                    if (br > 0) { const u32x4 pw = *(const u32x4*)(MG + r * DM + c);
                        v[0] += bf_lo(pw.x); v[1] += bf_hi(pw.x); v[2] += bf_lo(pw.y); v[3] += bf_hi(pw.y); v[4] += bf_lo(pw.z); v[5] += bf_hi(pw.z); v[6] += bf_lo(pw.w); v[7] += bf_hi(pw.w); }
                    u32x4 w; w.x = cvt_pk_bf16(v[0], v[1]); w.y = cvt_pk_bf16(v[2], v[3]); w.z = cvt_pk_bf16(v[4], v[5]); w.w = cvt_pk_bf16(v[6], v[7]);
                    *(u32x4*)(MG + r * DM + c) = w; }
                asm volatile("" ::: "memory"); }
    }
};
}

struct Params { const float* in[25]; float* out; unsigned char* ws; };
enum { I_X = 0, I_LN1G, I_LN1B, I_FF1IN, I_FF1OUT, I_WIN, I_BIN, I_CONVW, I_ALOG, I_DTB, I_GNG, I_RELB, I_SINKS, I_WGATE, I_BGATE, I_WBRA, I_WBRB, I_WBRC, I_WOUT, I_LN2G, I_LN2B, I_FF2IN, I_FF2OUT, I_LN3G, I_LN3B };

__device__ __forceinline__ float wave_sum(float v) {
#pragma unroll
    for (int o = 32; o >= 1; o >>= 1) v += __shfl_xor(v, o);
    return v;
}

__device__ __forceinline__ int colmap(int kind, int n) {
    if (kind == 1) { const int t = n >> 8, w = n & 255; return (w < 128) ? (t * 128 + w) : (DFF + t * 128 + (w - 128)); }
    if (kind == 2) return n < 1536 ? n : n + 8;
    return n;
}
__device__ __forceinline__ void cv_tiles(float* tile  , bf16_t* dst, int N, int K, const float* src, int ld, int kind, int bid, int nblk) {
    int tid_ = threadIdx.x; asm volatile("" : "+v"(tid_)); const int tid = tid_;
    const int tk = K / 64, ntile = (N / 64) * tk;
    for (int t = bid; t < ntile; t += nblk) {
        const int n0 = (t / tk) * 64, k0 = (t % tk) * 64;
#pragma unroll
        for (int i = 0; i < 8; ++i) { const int e = tid + i * 512, kk = e >> 6, nn = e & 63;
            tile[kk * 65 + nn] = src[(size_t)(k0 + kk) * ld + colmap(kind, n0 + nn)]; }
        __syncthreads();
        { const int nn = tid >> 3, k8 = (tid & 7) * 8; float v[8];
#pragma unroll
          for (int i = 0; i < 8; ++i) v[i] = tile[(k8 + i) * 65 + nn];
          u32x4 w; w.x = cvt_pk_bf16(v[0], v[1]); w.y = cvt_pk_bf16(v[2], v[3]); w.z = cvt_pk_bf16(v[4], v[5]); w.w = cvt_pk_bf16(v[6], v[7]);
          *(u32x4*)(dst + (size_t)(n0 + nn) * K + k0 + k8) = w; }
        __syncthreads();
    }
}

__device__ __forceinline__ void ln_phase(float* ldsf, const float* Y, const float* gam, const float* bet, float* XF, bf16_t* XB,
                         bool do_bg, const float* w_in, const float* b_in, const float* a_log, const float* dt_bias, float* BETA, float* GLOG) {
    int tid_ = threadIdx.x; asm volatile("" : "+v"(tid_)); const int tid = tid_, wv = tid >> 6, l = tid & 63;
    if (do_bg) { for (int e = tid; e < 8192; e += 512) ldsf[e] = w_in[(size_t)(e >> 3) * WIN_LD + 1536 + (e & 7)]; }
    __syncthreads();
    f32x4 gv[4], bv[4];
#pragma unroll
    for (int i = 0; i < 4; ++i) { gv[i] = *(const f32x4*)(gam + i * 256 + l * 4); bv[i] = *(const f32x4*)(bet + i * 256 + l * 4); }
    for (int row = blockIdx.x * 8 + wv; row < M_TOK; row += gridDim.x * 8) {
        f32x4 v[4];
#pragma unroll
        for (int i = 0; i < 4; ++i) v[i] = *(const f32x4*)(Y + (size_t)row * DM + i * 256 + l * 4);
        float s = 0.f;
#pragma unroll
        for (int i = 0; i < 4; ++i) s += (v[i][0] + v[i][1]) + (v[i][2] + v[i][3]);
        const float mean = wave_sum(s) * (1.0f / 1024.0f);
        float q = 0.f;
#pragma unroll
        for (int i = 0; i < 4; ++i) { v[i] = v[i] - mean; q += (v[i][0] * v[i][0] + v[i][1] * v[i][1]) + (v[i][2] * v[i][2] + v[i][3] * v[i][3]); }
        const float rstd = rsqrtf(wave_sum(q) * (1.0f / 1024.0f) + 1e-5f);
#pragma unroll
        for (int i = 0; i < 4; ++i) {
            v[i] = v[i] * rstd * gv[i] + bv[i];
            *(f32x4*)(XF + (size_t)row * DM + i * 256 + l * 4) = v[i];
            u32x2 w; w.x = cvt_pk_bf16(v[i][0], v[i][1]); w.y = cvt_pk_bf16(v[i][2], v[i][3]);
            *(u32x2*)(XB + (size_t)row * DM + i * 256 + l * 4) = w;
        }
        if (do_bg) {
            float d[8];
#pragma unroll
            for (int j = 0; j < 8; ++j) d[j] = 0.f;
#pragma unroll
            for (int i = 0; i < 4; ++i)
#pragma unroll
                for (int jj = 0; jj < 4; ++jj) { const int k = i * 256 + l * 4 + jj; const f32x4 w0 = *(const f32x4*)(ldsf + k * 8), w1 = *(const f32x4*)(ldsf + k * 8 + 4); const float x = v[i][jj];
                    d[0] += x * w0[0]; d[1] += x * w0[1]; d[2] += x * w0[2]; d[3] += x * w0[3]; d[4] += x * w1[0]; d[5] += x * w1[1]; d[6] += x * w1[2]; d[7] += x * w1[3]; }
#pragma unroll
            for (int j = 0; j < 8; ++j) d[j] = wave_sum(d[j]);
            if (l == 0) {
                f32x4 bo, go;
#pragma unroll
                for (int h = 0; h < 4; ++h) {
                    bo[h] = 1.0f / (1.0f + expf(-(d[h] + b_in[1536 + h])));
                    const float xa = d[4 + h] + b_in[1540 + h] + dt_bias[h];
                    const float sp = xa > 20.f ? xa : log1pf(expf(xa));
                    go[h] = -expf(a_log[h]) * sp;
                }
                *(f32x4*)(BETA + (size_t)row * 4) = bo; *(f32x4*)(GLOG + (size_t)row * 4) = go;
            }
        }
    }
}

__device__ __forceinline__ void prep_phase(const bf16_t* PROJ, const float* conv_w, bf16_t* QN, bf16_t* KN, bf16_t* VC) {
    int tid_ = threadIdx.x; asm volatile("" : "+v"(tid_)); const int tid = tid_, wv = tid >> 6, l = tid & 63;
    for (int r = blockIdx.x * 8 + wv; r < M_TOK * 12; r += gridDim.x * 8) {
        const int tok = r / 12, wh = r - tok * 12, which = wh >> 2, h = wh & 3;
        const int ch = which * 512 + h * 128 + 2 * l;
        const int tpos = tok & (SEQ - 1);
        float a0 = 0.f, a1 = 0.f;
#pragma unroll
        for (int i = 0; i < 4; ++i) {
            if (tpos - 3 + i >= 0) {
                const unsigned pv = *(const unsigned*)(PROJ + (size_t)(tok - 3 + i) * PROJ_LD + ch);
                const f32x2 cw = *(const f32x2*)(conv_w + i * 1536 + ch);
                a0 += cw[0] * bf_lo(pv); a1 += cw[1] * bf_hi(pv);
            }
        }
        a0 = a0 / (1.0f + expf(-a0)); a1 = a1 / (1.0f + expf(-a1));
        if (which < 2) {
            const float ss = wave_sum(a0 * a0 + a1 * a1);
            float rs = rsqrtf(ss + 1e-6f);
            if (which == 0) rs *= 0.08838834764831845f;
            a0 *= rs; a1 *= rs;
        }
        bf16_t* dst = which == 0 ? QN : (which == 1 ? KN : VC);
        *(unsigned*)(dst + (size_t)tok * 512 + h * 128 + 2 * l) = cvt_pk_bf16(a0, a1);
    }
}

__device__ __forceinline__ void delta_recurrent(float* ldsf, int bh, bf16_t* PROJ, const bf16_t* QN, const bf16_t* KN, const bf16_t* VC, const float* BETA, const float* GLOG, const float* norm_g) {
    int tid_ = threadIdx.x; asm volatile("" : "+v"(tid_)); const int tid = tid_, wv = tid >> 6, l = tid & 63, c = l & 15, gq = l >> 4;
    const int b = bh >> 2, h = bh & 3;
    float* qs = ldsf; float* ks = ldsf + 8192; float* vs = ldsf + 16384; float* Os = ldsf + 24576; float* al = ldsf + 32768; float* be = al + 64;
    float s[32];
#pragma unroll
    for (int i = 0; i < 32; ++i) s[i] = 0.f;
    for (int n = 0; n < NCHUNK; ++n) {
        const size_t row0 = (size_t)b * SEQ + n * 64;
        __syncthreads();
#pragma unroll
        for (int it = 0; it < 2; ++it) { const int e = tid + it * 512, t = e >> 4, p8 = (e & 15) * 8;
            const size_t g = (row0 + t) * 512 + h * 128 + p8;
            const u32x4 qw = *(const u32x4*)(QN + g), kw = *(const u32x4*)(KN + g), vw = *(const u32x4*)(VC + g);
            float* qd = qs + t * 128 + p8; float* kd = ks + t * 128 + p8; float* vd = vs + t * 128 + p8;
            *(f32x4*)qd = (f32x4){bf_lo(qw.x), bf_hi(qw.x), bf_lo(qw.y), bf_hi(qw.y)}; *(f32x4*)(qd + 4) = (f32x4){bf_lo(qw.z), bf_hi(qw.z), bf_lo(qw.w), bf_hi(qw.w)};
            *(f32x4*)kd = (f32x4){bf_lo(kw.x), bf_hi(kw.x), bf_lo(kw.y), bf_hi(kw.y)}; *(f32x4*)(kd + 4) = (f32x4){bf_lo(kw.z), bf_hi(kw.z), bf_lo(kw.w), bf_hi(kw.w)};
            *(f32x4*)vd = (f32x4){bf_lo(vw.x), bf_hi(vw.x), bf_lo(vw.y), bf_hi(vw.y)}; *(f32x4*)(vd + 4) = (f32x4){bf_lo(vw.z), bf_hi(vw.z), bf_lo(vw.w), bf_hi(vw.w)};
        }
        if (tid < 64) { al[tid] = expf(GLOG[(row0 + tid) * 4 + h]); be[tid] = BETA[(row0 + tid) * 4 + h]; }
        __syncthreads();
        for (int t = 0; t < 64; ++t) {
            const float a = al[t], bt = be[t];
            float kk[32], qq[32];
#pragma unroll
            for (int i = 0; i < 8; ++i) { const f32x4 kv = *(const f32x4*)(ks + t * 128 + gq * 32 + i * 4); kk[4 * i] = kv[0]; kk[4 * i + 1] = kv[1]; kk[4 * i + 2] = kv[2]; kk[4 * i + 3] = kv[3];
                                          const f32x4 qv = *(const f32x4*)(qs + t * 128 + gq * 32 + i * 4); qq[4 * i] = qv[0]; qq[4 * i + 1] = qv[1]; qq[4 * i + 2] = qv[2]; qq[4 * i + 3] = qv[3]; }
            float k0 = 0.f, k1 = 0.f, k2 = 0.f, k3 = 0.f;
#pragma unroll
            for (int i = 0; i < 32; i += 4) { k0 += kk[i] * s[i]; k1 += kk[i + 1] * s[i + 1]; k2 += kk[i + 2] * s[i + 2]; k3 += kk[i + 3] * s[i + 3]; }
            float ksum = (k0 + k1) + (k2 + k3);
            ksum += __shfl_xor(ksum, 16); ksum += __shfl_xor(ksum, 32);
            const float vn = bt * (vs[t * 128 + wv * 16 + c] - a * ksum);
#pragma unroll
            for (int i = 0; i < 32; ++i) s[i] = a * s[i] + kk[i] * vn;
            float o0 = 0.f, o1 = 0.f, o2 = 0.f, o3 = 0.f;
#pragma unroll
            for (int i = 0; i < 32; i += 4) { o0 += qq[i] * s[i]; o1 += qq[i + 1] * s[i + 1]; o2 += qq[i + 2] * s[i + 2]; o3 += qq[i + 3] * s[i + 3]; }
            float os = (o0 + o1) + (o2 + o3);
            os += __shfl_xor(os, 16); os += __shfl_xor(os, 32);
            if (gq == 0) Os[t * 128 + wv * 16 + c] = os;
        }
        __syncthreads();
        {
            const int t = tid >> 3, j8 = tid & 7;
            float o[16]; float ss = 0.f;
#pragma unroll
            for (int i = 0; i < 4; ++i) { const f32x4 ov = *(const f32x4*)(Os + t * 128 + j8 * 16 + i * 4); o[4 * i] = ov[0]; o[4 * i + 1] = ov[1]; o[4 * i + 2] = ov[2]; o[4 * i + 3] = ov[3]; }
#pragma unroll
            for (int i = 0; i < 16; ++i) ss += o[i] * o[i];
            ss += __shfl_xor(ss, 1); ss += __shfl_xor(ss, 2); ss += __shfl_xor(ss, 4);
            const float rs = rsqrtf(ss * (1.0f / 128.0f) + 1e-6f);
            bf16_t* prow = PROJ + (row0 + t) * PROJ_LD + h * 128 + j8 * 16;
            const u32x4 z0 = *(const u32x4*)(prow + C_ZA), z1 = *(const u32x4*)(prow + C_ZA + 8);
            const unsigned zw[8] = {z0.x, z0.y, z0.z, z0.w, z1.x, z1.y, z1.z, z1.w};
            unsigned ow[8];
#pragma unroll
            for (int i = 0; i < 8; ++i) {
                const float za = bf_lo(zw[i]), zb = bf_hi(zw[i]);
                const float ra = o[2 * i] * rs * norm_g[j8 * 16 + 2 * i] * (za / (1.0f + expf(-za)));
                const float rb = o[2 * i + 1] * rs * norm_g[j8 * 16 + 2 * i + 1] * (zb / (1.0f + expf(-zb)));
                ow[i] = cvt_pk_bf16(ra, rb);
            }
            *(u32x4*)(prow + C_QA) = (u32x4){ow[0], ow[1], ow[2], ow[3]}; *(u32x4*)(prow + C_QA + 8) = (u32x4){ow[4], ow[5], ow[6], ow[7]};
        }
    }
}

template <int D, bool MODE_C>
__device__ __forceinline__ void attn_half(unsigned char* hl, bf16_t* PROJ, int b, int n, int qcol, int kcol, int vcol, const float* rb, float slope, float sink, int htid) {
    constexpr int NPREV = MODE_C ? 2 : 8;
    constexpr int KP = D + 8;
    bf16_t* Ks = (bf16_t*)hl; bf16_t* Vt = (bf16_t*)(hl + 64 * KP * 2); float* rbs = (float*)(hl + 64 * KP * 2 + D * 72 * 2);
    const int w4 = htid >> 6, l = htid & 63, lr = l & 15, lg = l >> 4, q0 = w4 * 16;
    const float scale = MODE_C ? 0.125f : 0.08838834764831845f;
    const size_t qrow = (size_t)b * SEQ + n * 64 + q0 + lr;
    bf16x8 qf[D / 32];
#pragma unroll
    for (int ks = 0; ks < D / 32; ++ks) qf[ks] = *(const bf16x8*)(PROJ + qrow * PROJ_LD + qcol + ks * 32 + lg * 8);
    if (!MODE_C) { if (htid < 192) rbs[htid] = rb[htid]; }
    f32x4 o[D / 16];
#pragma unroll
    for (int i = 0; i < D / 16; ++i) o[i] = (f32x4){0.f, 0.f, 0.f, 0.f};
    float mrun = -1e30f, lsum = 0.f;
    const int kc0 = n - NPREV < 0 ? 0 : n - NPREV;
    for (int kc = kc0; kc <= n; ++kc) {
        __syncthreads();
        const size_t krow0 = (size_t)b * SEQ + kc * 64;
#pragma unroll
        for (int it = 0; it < (64 * (D / 8)) / 256; ++it) {
            const int e = htid + it * 256, r = e / (D / 8), p8 = e % (D / 8);
            *(u32x4*)(Ks + r * KP + p8 * 8) = *(const u32x4*)(PROJ + (krow0 + r) * PROJ_LD + kcol + p8 * 8);
        }
#pragma unroll
        for (int it = 0; it < (64 * (D / 8)) / 256; ++it) {
            const int e = htid + it * 256, r = e & 63, p8 = e >> 6;
            const u32x4 vw = *(const u32x4*)(PROJ + (krow0 + r) * PROJ_LD + vcol + p8 * 8);
            bf16_t* vd = Vt + (p8 * 8) * 72 + r;
            vd[0] = (bf16_t)(vw.x & 0xffff); vd[72] = (bf16_t)(vw.x >> 16); vd[144] = (bf16_t)(vw.y & 0xffff); vd[216] = (bf16_t)(vw.y >> 16);
            vd[288] = (bf16_t)(vw.z & 0xffff); vd[360] = (bf16_t)(vw.z >> 16); vd[432] = (bf16_t)(vw.w & 0xffff); vd[504] = (bf16_t)(vw.w >> 16);
        }
        __syncthreads();
        f32x4 st[4];
#pragma unroll
        for (int kt = 0; kt < 4; ++kt) {
            st[kt] = (f32x4){0.f, 0.f, 0.f, 0.f};
#pragma unroll
            for (int ks = 0; ks < D / 32; ++ks) {
                const bf16x8 a = *(const bf16x8*)(Ks + (kt * 16 + lr) * KP + ks * 32 + lg * 8);
                st[kt] = __builtin_amdgcn_mfma_f32_16x16x32_bf16(a, qf[ks], st[kt], 0, 0, 0);
            }
        }
        const int dbase = (n - kc) * 64 + q0 + lr;
        float mc = -1e30f;
#pragma unroll
        for (int kt = 0; kt < 4; ++kt)
#pragma unroll
            for (int j = 0; j < 4; ++j) {
                const int dist = dbase - (kt * 16 + lg * 4 + j);
                float sv;
                if (MODE_C) sv = st[kt][j] * scale - slope * fabsf((float)dist);
                else { const int idx = (dist > 128 ? 128 : dist) + 63; sv = st[kt][j] * scale + rbs[idx]; }
                st[kt][j] = sv; mc = fmaxf(mc, sv);
            }
        mc = fmaxf(mc, __shfl_xor(mc, 16)); mc = fmaxf(mc, __shfl_xor(mc, 32));
        const float mnew = fmaxf(mrun, mc), corr = __expf(mrun - mnew);
        mrun = mnew;
        float ps = 0.f;
#pragma unroll
        for (int kt = 0; kt < 4; ++kt)
#pragma unroll
            for (int j = 0; j < 4; ++j) { const float p = __expf(st[kt][j] - mnew); st[kt][j] = p; ps += p; }
        lsum = lsum * corr + ps;
#pragma unroll
        for (int i = 0; i < D / 16; ++i) o[i] = o[i] * corr;
        bf16x8 pb[2];
#pragma unroll
        for (int k2 = 0; k2 < 2; ++k2) {
            u32x4 w; w.x = cvt_pk_bf16(st[2 * k2][0], st[2 * k2][1]); w.y = cvt_pk_bf16(st[2 * k2][2], st[2 * k2][3]);
            w.z = cvt_pk_bf16(st[2 * k2 + 1][0], st[2 * k2 + 1][1]); w.w = cvt_pk_bf16(st[2 * k2 + 1][2], st[2 * k2 + 1][3]);
            pb[k2] = __builtin_bit_cast(bf16x8, w);
        }
#pragma unroll
        for (int dt = 0; dt < D / 16; ++dt)
#pragma unroll
            for (int k2 = 0; k2 < 2; ++k2) {
                const bf16_t* vp = Vt + (dt * 16 + lr) * 72 + lg * 4;
                const u32x2 lo = *(const u32x2*)(vp + (2 * k2) * 16), hi = *(const u32x2*)(vp + (2 * k2 + 1) * 16);
                const u32x4 aw = (u32x4){lo.x, lo.y, hi.x, hi.y};
                o[dt] = __builtin_amdgcn_mfma_f32_16x16x32_bf16(__builtin_bit_cast(bf16x8, aw), pb[k2], o[dt], 0, 0, 0);
            }
    }
    lsum += __shfl_xor(lsum, 16); lsum += __shfl_xor(lsum, 32);
    if (MODE_C) lsum += __expf(sink - mrun);
    const float inv = 1.0f / lsum;
    bf16_t* orow = PROJ + qrow * PROJ_LD + qcol + lg * 4;
#pragma unroll
    for (int dt = 0; dt < D / 16; ++dt) {
        u32x2 w; w.x = cvt_pk_bf16(o[dt][0] * inv, o[dt][1] * inv); w.y = cvt_pk_bf16(o[dt][2] * inv, o[dt][3] * inv);
        *(u32x2*)(orow + dt * 16) = w;
    }
}
constexpr int ATT_HALF_BYTES = 40960;
__device__ __forceinline__ void attn_item(unsigned char* lds, int it, bf16_t* PROJ, const float* rel_bias, const float* sinks) {
    int tid_ = threadIdx.x; asm volatile("" : "+v"(tid_)); const int tid = tid_, half = tid >> 8, htid = tid & 255;
    unsigned char* hl = lds + half * ATT_HALF_BYTES;
    if (it < 512) {
        const int b = it >> 6, n = (it >> 1) & 31, h = (it & 1) * 2 + half;
        attn_half<128, false>(hl, PROJ, b, n, C_QB + h * 128, C_KB + h * 128, C_VB + h * 128, rel_bias + h * 192, 0.f, 0.f, htid);
    } else {
        const int i2 = it - 512, b = i2 >> 7, n = (i2 >> 2) & 31, hq = (i2 & 3) * 2 + half, hkv = hq >> 2;
        const float slope = exp2f(-(float)(hq + 1));
        attn_half<64, true>(hl, PROJ, b, n, C_QC + hq * 64, C_KC + hkv * 64, C_VC + hkv * 64, nullptr, slope, sinks[hq], htid);
    }
}

constexpr int LDS_BYTES = 135168;
constexpr int SCAN_BLOCKS = 32;

__device__ __forceinline__ const Params* get_pp() {
    const unsigned char* ka = (const unsigned char*)__builtin_amdgcn_kernarg_segment_ptr(); asm volatile("" : "+s"(ka)); return (const Params*)ka;
}
#define WSPTR(T, off) ((T*)(ws + (off)))
#define PH_BEGIN const Params* pp = get_pp(); unsigned char* ws = pp->ws; (void)ws; int G = G0, bid = bid0; asm volatile("" : "+s"(G), "+s"(bid));

template <int l>
__device__ __forceinline__ void layer_body(cg::grid_group& grid, const int G0, const int bid0, unsigned char* lds, LAS unsigned char* ldsl, float* ldsf, const float alpha) {
        { PH_BEGIN
          pg8::Gemm g{WSPTR(bf16_t, WS_XB), WSPTR(bf16_t, WS_SLOTA), M_TOK, 8192, DM, DM, DM}; pg8::StaticOrder S; S.init(M_TOK, 8192, G, bid); pg8::EpiSwiGLU E{WSPTR(bf16_t, WS_H)};
          pg8::gemm_phase(ldsl, g, S, E); }
        grid.sync();
        { PH_BEGIN
          pg8::Gemm g{WSPTR(bf16_t, WS_H), WSPTR(bf16_t, WS_SLOTB), M_TOK, DM, DFF, DFF, DFF}; pg8::StaticOrder S; S.init(M_TOK, DM, G, bid);
          pg8::EpiResid E{l == 0 ? pp->in[I_X] : (const float*)pp->out, WSPTR(float, WS_YFFN), alpha, 0.5f};
          pg8::gemm_phase(ldsl, g, S, E); }
        grid.sync();
        { PH_BEGIN
          const float* w_in = pp->in[I_WIN] + (size_t)l * DM * WIN_LD;
          cv_tiles(ldsf, WSPTR(bf16_t, WS_SLOTA), PROJ_LD, DM, w_in, WIN_LD, 2, bid, G);
          cv_tiles(ldsf, WSPTR(bf16_t, WS_SLOTB + SB_WGATE), 3072, DM, pp->in[I_WGATE] + (size_t)l * DM * 3072, 3072, 0, bid, G);
          cv_tiles(ldsf, WSPTR(bf16_t, WS_SLOTB + SB_WBR), 1024, 512, pp->in[I_WBRA] + (size_t)l * 512 * DM, DM, 0, bid, G);
          cv_tiles(ldsf, WSPTR(bf16_t, WS_SLOTB + SB_WBR) + 1024 * 512, 1024, 512, pp->in[I_WBRB] + (size_t)l * 512 * DM, DM, 0, bid, G);
          cv_tiles(ldsf, WSPTR(bf16_t, WS_SLOTB + SB_WBR) + 2048 * 512, 1024, 512, pp->in[I_WBRC] + (size_t)l * 512 * DM, DM, 0, bid, G);
          cv_tiles(ldsf, WSPTR(bf16_t, WS_SLOTB + SB_WOUT), DM, DM, pp->in[I_WOUT] + (size_t)l * DM * DM, DM, 0, bid, G);
          ln_phase(ldsf, WSPTR(float, WS_YFFN), pp->in[I_LN1G] + l * DM, pp->in[I_LN1B] + l * DM, pp->out, WSPTR(bf16_t, WS_XB), true, w_in, pp->in[I_BIN] + (size_t)l * WIN_LD,
                   pp->in[I_ALOG] + l * 4, pp->in[I_DTB] + l * 4, WSPTR(float, WS_BETA), WSPTR(float, WS_GLOG)); }
        grid.sync();
        { PH_BEGIN
          pg8::Gemm g{WSPTR(bf16_t, WS_XB), WSPTR(bf16_t, WS_SLOTA), M_TOK, PROJ_LD, DM, DM, DM}; pg8::StaticOrder S; S.init(M_TOK, PROJ_LD, G, bid);
          pg8::EpiBiasBf16<0, 1536> E{WSPTR(bf16_t, WS_PROJ), PROJ_LD, pp->in[I_BIN] + (size_t)l * WIN_LD};
          pg8::gemm_phase(ldsl, g, S, E); }
        grid.sync();
        { PH_BEGIN
          prep_phase(WSPTR(bf16_t, WS_PROJ), pp->in[I_CONVW] + (size_t)l * 4 * 1536, WSPTR(bf16_t, WS_QN), WSPTR(bf16_t, WS_KN), WSPTR(bf16_t, WS_VC)); }
        grid.sync();
        { PH_BEGIN
          if (bid < SCAN_BLOCKS) delta_recurrent(ldsf, bid, WSPTR(bf16_t, WS_PROJ), WSPTR(bf16_t, WS_QN), WSPTR(bf16_t, WS_KN), WSPTR(bf16_t, WS_VC), WSPTR(float, WS_BETA), WSPTR(float, WS_GLOG), pp->in[I_GNG] + l * 128);
          else { const float* relb = pp->in[I_RELB] + l * 4 * 192; const float* sinks = pp->in[I_SINKS] + l * 8;
                 for (int it = bid - SCAN_BLOCKS; it < 1536; it += G - SCAN_BLOCKS) attn_item(lds, it, WSPTR(bf16_t, WS_PROJ), relb, sinks); } }
        grid.sync();
        { PH_BEGIN
          pg8::Gemm g{WSPTR(bf16_t, WS_XB), WSPTR(bf16_t, WS_SLOTB + SB_WGATE), M_TOK, 3072, DM, DM, DM}; pg8::StaticOrder S; S.init(M_TOK, 3072, G, bid);
          pg8::EpiBiasBf16<1, (1 << 30)> E{WSPTR(bf16_t, WS_GATES), 3072, pp->in[I_BGATE] + (size_t)l * 3072};
          pg8::gemm_phase(ldsl, g, S, E); }
        grid.sync();
        { PH_BEGIN
          pg8::Gemm g{WSPTR(bf16_t, WS_PROJ), WSPTR(bf16_t, WS_SLOTB + SB_WBR), M_TOK, 3072, 512, PROJ_LD, 512}; pg8::BranchOrder S{G, bid}; pg8::EpiBranch E{WSPTR(bf16_t, WS_GATES), WSPTR(bf16_t, WS_MERGED)};
          pg8::gemm_phase(ldsl, g, S, E); }
        grid.sync();
        { PH_BEGIN
          pg8::Gemm g{WSPTR(bf16_t, WS_MERGED), WSPTR(bf16_t, WS_SLOTB + SB_WOUT), M_TOK, DM, DM, DM, DM}; pg8::StaticOrder S; S.init(M_TOK, DM, G, bid);
          pg8::EpiResid E{(const float*)pp->out, WSPTR(float, WS_YMIX), alpha, 1.0f};
          pg8::gemm_phase(ldsl, g, S, E); }
        grid.sync();
        { PH_BEGIN
          cv_tiles(ldsf, WSPTR(bf16_t, WS_SLOTA), 8192, DM, pp->in[I_FF2IN] + (size_t)l * DM * 8192, 8192, 1, bid, G);
          cv_tiles(ldsf, WSPTR(bf16_t, WS_SLOTB), DM, DFF, pp->in[I_FF2OUT] + (size_t)l * DFF * DM, DM, 0, bid, G);
          ln_phase(ldsf, WSPTR(float, WS_YMIX), pp->in[I_LN2G] + l * DM, pp->in[I_LN2B] + l * DM, pp->out, WSPTR(bf16_t, WS_XB), false, nullptr, nullptr, nullptr, nullptr, nullptr, nullptr); }
        grid.sync();
        { PH_BEGIN
          pg8::Gemm g{WSPTR(bf16_t, WS_XB), WSPTR(bf16_t, WS_SLOTA), M_TOK, 8192, DM, DM, DM}; pg8::StaticOrder S; S.init(M_TOK, 8192, G, bid); pg8::EpiSwiGLU E{WSPTR(bf16_t, WS_H)};
          pg8::gemm_phase(ldsl, g, S, E); }
        grid.sync();
        { PH_BEGIN
          pg8::Gemm g{WSPTR(bf16_t, WS_H), WSPTR(bf16_t, WS_SLOTB), M_TOK, DM, DFF, DFF, DFF}; pg8::StaticOrder S; S.init(M_TOK, DM, G, bid);
          pg8::EpiResid E{(const float*)pp->out, WSPTR(float, WS_YFFN), alpha, 0.5f};
          pg8::gemm_phase(ldsl, g, S, E); }
        grid.sync();
        { PH_BEGIN
          if (l == 0) {
              cv_tiles(ldsf, WSPTR(bf16_t, WS_SLOTA), 8192, DM, pp->in[I_FF1IN] + (size_t)DM * 8192, 8192, 1, bid, G);
              cv_tiles(ldsf, WSPTR(bf16_t, WS_SLOTB), DM, DFF, pp->in[I_FF1OUT] + (size_t)DFF * DM, DM, 0, bid, G);
          }
          ln_phase(ldsf, WSPTR(float, WS_YFFN), pp->in[I_LN3G] + l * DM, pp->in[I_LN3B] + l * DM, pp->out, WSPTR(bf16_t, WS_XB), false, nullptr, nullptr, nullptr, nullptr, nullptr, nullptr); }
        if (l == 0) grid.sync();
}

__global__ void __launch_bounds__(512, 2) fwd_kernel(Params p_unused) {
    extern __shared__ __attribute__((aligned(16))) unsigned char lds[];
    cg::grid_group grid = cg::this_grid();
    const int G0 = gridDim.x, bid0 = blockIdx.x;
    LAS unsigned char* ldsl = (LAS unsigned char*)lds; float* ldsf = (float*)lds;
    const float alpha = 1.41421356237309515f;

    { PH_BEGIN
      cv_tiles(ldsf, WSPTR(bf16_t, WS_SLOTA), 8192, DM, pp->in[I_FF1IN], 8192, 1, bid, G);
      cv_tiles(ldsf, WSPTR(bf16_t, WS_SLOTB), DM, DFF, pp->in[I_FF1OUT], DM, 0, bid, G);
      const float* x = pp->in[I_X]; bf16_t* XB = WSPTR(bf16_t, WS_XB);
      const int tid = threadIdx.x;
      for (size_t i = ((size_t)bid * 512 + tid) * 4; i < (size_t)M_TOK * DM; i += (size_t)G * 512 * 4) {
          const f32x4 v = *(const f32x4*)(x + i); u32x2 w; w.x = cvt_pk_bf16(v[0], v[1]); w.y = cvt_pk_bf16(v[2], v[3]); *(u32x2*)(XB + i) = w; } }
    grid.sync();

    layer_body<0>(grid, G0, bid0, lds, ldsl, ldsf, alpha);
    layer_body<1>(grid, G0, bid0, lds, ldsl, ldsf, alpha);
}


extern "C" void kernel_launch(void* const* d_in, const int* in_sizes, int n_in, void* d_out, int out_size, void* d_ws, size_t ws_size, hipStream_t stream) {
    static int grid_blocks = 0;
    if (!grid_blocks) {
        int dev = 0, cus = 0, per_cu = 0;
        (void)hipGetDevice(&dev);
        (void)hipDeviceGetAttribute(&cus, hipDeviceAttributeMultiprocessorCount, dev);
        if (hipFuncSetAttribute((const void*)fwd_kernel, hipFuncAttributeMaxDynamicSharedMemorySize, LDS_BYTES) != hipSuccess) fprintf(stderr, "kernel_launch: hipFuncSetAttribute failed\n");
        if (hipOccupancyMaxActiveBlocksPerMultiprocessor(&per_cu, (const void*)fwd_kernel, 512, LDS_BYTES) != hipSuccess || per_cu < 1) { fprintf(stderr, "kernel_launch: occupancy query says %d\n", per_cu); per_cu = 1; }
        (void)hipGetLastError();
        grid_blocks = cus * per_cu;
        if (grid_blocks > 256) grid_blocks = 256;
        if (ws_size < WS_END || n_in != 25) fprintf(stderr, "kernel_launch: workspace %zu < %zu or n_in %d != 25\n", ws_size, (size_t)WS_END, n_in);
        fprintf(stderr, "kernel_launch: grid %d (cus %d x %d), ws %zu\n", grid_blocks, cus, per_cu, ws_size);
    }
    Params p{};
    for (int i = 0; i < 25; ++i) p.in[i] = (const float*)d_in[i];
    p.out = (float*)d_out; p.ws = (unsigned char*)d_ws;
    void* args[] = {&p};
    hipError_t e = hipLaunchCooperativeKernel((const void*)fwd_kernel, dim3(grid_blocks), dim3(512), args, LDS_BYTES, stream);
    if (e != hipSuccess) fprintf(stderr, "cooperative launch failed: %s (grid %d)\n", hipGetErrorString(e), grid_blocks);
}
```

```cpp
#include <hip/hip_runtime.h>
#include <hip/hip_cooperative_groups.h>
#include <cstdio>
namespace cg = cooperative_groups;

#define LAS __attribute__((address_space(3)))
typedef unsigned short bf16_t;
typedef short bf16x8 __attribute__((ext_vector_type(8)));
typedef float f32x4 __attribute__((ext_vector_type(4)));
typedef float f32x2 __attribute__((ext_vector_type(2)));
typedef unsigned u32x4 __attribute__((ext_vector_type(4)));
typedef unsigned u32x2 __attribute__((ext_vector_type(2)));

constexpr int M_TOK = 16384, DM = 1024, DFF = 4096, SEQ = 2048, NCHUNK = 32;
constexpr int PROJ_LD = 4352;
constexpr int C_QA = 0, C_KA = 512, C_VA = 1024, C_ZA = 1536, C_QB = 2048, C_KB = 2560, C_VB = 3072, C_QC = 3584, C_KC = 4096, C_VC = 4224;
constexpr int WIN_LD = 4360;
constexpr size_t MiB = 1ull << 20;
constexpr size_t WS_SLOTA = 0, WS_SLOTB = 16 * MiB, WS_XB = 32 * MiB, WS_R = 64 * MiB;
constexpr size_t WS_H = WS_R, WS_YFFN = WS_R + 128 * MiB;
constexpr size_t WS_PROJ = WS_R, WS_YMIX = WS_R;
constexpr size_t WS_R2 = WS_R + 136 * MiB;
constexpr size_t WS_QN = WS_R2, WS_KN = WS_R2 + 16 * MiB, WS_VC = WS_R2 + 32 * MiB;
constexpr size_t WS_GATES = WS_R2;
constexpr size_t WS_MERGED = WS_R2 + 96 * MiB;
constexpr size_t WS_BETA = WS_R2 + 128 * MiB, WS_GLOG = WS_BETA + 256 * 1024;
constexpr size_t WS_END = WS_GLOG + 256 * 1024;
constexpr size_t SB_WGATE = 0, SB_WBR = 6 * MiB, SB_WOUT = 9 * MiB;

typedef __bf16 bf16x2_n __attribute__((ext_vector_type(2)));
__device__ __forceinline__ unsigned cvt_pk_bf16(float lo, float hi) { const f32x2 v = {lo, hi}; const bf16x2_n b = __builtin_convertvector(v, bf16x2_n); return __builtin_bit_cast(unsigned, b); }
__device__ __forceinline__ float bf_lo(unsigned w) { return __uint_as_float(w << 16); }
__device__ __forceinline__ float bf_hi(unsigned w) { return __uint_as_float(w & 0xffff0000u); }
__device__ __forceinline__ float bf2f(bf16_t b) { return __uint_as_float(((unsigned)b) << 16); }
__device__ __forceinline__ float fast_sigmoid(float x) { return __builtin_amdgcn_rcpf(1.0f + __expf(-x)); }
__device__ __forceinline__ float fast_silu(float x) { return x * fast_sigmoid(x); }

namespace pg8 {
constexpr int BM = 256, BK = 64, HALF = 128, HTB = HALF * BK * 2  , STAGE_BYTES = 8 * HTB, NXCD = 8, WGM = 8;

__host__ __device__ __forceinline__ int lds_byte(int r, int c) { const int st = (r >> 4) * 2 + (c >> 5), rr = r & 15, cc = c & 31, ob = rr * 64 + cc * 2; return st * 1024 + (ob ^ (((ob >> 9) & 1) << 5)); }
__host__ __device__ __forceinline__ void stage_rc(int b, int& R, int& C) { const int st = b / 1024, sb = b % 1024, swz = sb ^ (((sb >> 9) & 1) << 5); R = (st >> 1) * 16 + swz / 64; C = (st & 1) * 32 + (swz % 64) / 2; }
__host__ __device__ __forceinline__ int perm32(int rho) { const int n = rho >> 4, i = rho & 15; return 8 * (i >> 2) + 4 * n + (i & 3); }

struct Unit { int pm, pn; };
struct Gemm { const bf16_t* A; const bf16_t* Bt; int M, N, K, lda, ldb; };

__device__ __forceinline__ void remap_tile(int wgid, int nM, int nN, int& pm, int& pn) {
    const int nwg = nM * nN;
    { const int q = nwg / NXCD, r = nwg % NXCD, xcd = wgid % NXCD, off = wgid / NXCD; wgid = (xcd < r ? xcd * (q + 1) : r * (q + 1) + (xcd - r) * q) + off; }
    const int nig = WGM * nN, gid = wgid / nig, fm = gid * WGM, gsz = (nM - fm) < WGM ? (nM - fm) : WGM;
    pm = fm + ((wgid % nig) % gsz); pn = (wgid % nig) / gsz;
}
struct StaticOrder {
    int nM, nN, nwg, G, c;
    __device__ void init(int M, int N, int G_, int c_) { nM = M / BM; nN = N / BM; nwg = nM * nN; G = G_; c = c_; }
    __device__ bool next(int i, Unit& u) const {
        const long L = (long)i * G + c; if (L >= nwg) return false;
        remap_tile((int)L, nM, nN, u.pm, u.pn); return true;
    }
    __device__ __forceinline__ int a_coloff(const Unit&) const { return 0; }
};
struct BranchOrder {
    int G, c;
    __device__ bool next(int i, Unit& u) const {
        const int ti = i / 3, br = i - 3 * ti; const long L = (long)ti * G + c; if (L >= 256) return false;
        int pm, pn4; remap_tile((int)L, 64, 4, pm, pn4); u.pm = pm; u.pn = br * 4 + pn4; return true;
    }
    __device__ __forceinline__ int a_coloff(const Unit& u) const { const int br = u.pn >> 2; return br == 0 ? C_QA : (br == 1 ? C_QB : C_QC); }
};

template <class Epi, class Sched>
__device__ __forceinline__ void gemm_phase(LAS unsigned char* lds, const Gemm g, const Sched& S, const Epi& E) {
    int tid_ = threadIdx.x; asm volatile("" : "+v"(tid_));
    const int tid = tid_, wid = __builtin_amdgcn_readfirstlane(tid >> 6), lane = tid & 63, wr = wid >> 2, wc = wid & 3, fr = lane & 15, fq = lane >> 4;
    const int K = g.K, nt = K / BK;
    unsigned voffA[2], voffB[2];
#pragma unroll
    for (int i = 0; i < 2; ++i) { int R, C; stage_rc(tid * 16 + i * 8192, R, C); const int Rb = Epi::PERM ? ((R & ~31) + perm32(R & 31)) : R;
        voffA[i] = (unsigned)(R * g.lda + C) * 2u; voffB[i] = (unsigned)(Rb * g.ldb + C) * 2u; }
    const size_t kstep = (size_t)(BK * 2);
    const size_t hstepA = (size_t)HALF * g.lda * 2, hstepB = (size_t)HALF * g.ldb * 2;
    const size_t tstepA = 2 * hstepA, tstepB = 2 * hstepB;
    const unsigned ldsw = (unsigned)wid * 1024u;
    const int aoff = lds_byte(wr * 64 + fr, fq * 8), boff = lds_byte(wc * 32 + fr, fq * 8);
#define PG8_SA(b, h) (((b) * 2 + (h)) * HTB)
#define PG8_SB(b, h) ((4 + (b) * 2 + (h)) * HTB)
#define PG8_STAGE(bufoff, gbase, voff) do { _Pragma("unroll") for (int _i = 0; _i < 2; ++_i) \
        __builtin_amdgcn_global_load_lds((const unsigned*)((const char*)(gbase) + (voff)[_i]), (LAS unsigned*)(lds + (bufoff) + ldsw + _i * 8192), 16, 0, 0); } while (0)
#define PG8_LDA(dst, b, h) do { _Pragma("unroll") for (int m = 0; m < 4; ++m) _Pragma("unroll") for (int k = 0; k < 2; ++k) dst[m][k] = *(const LAS bf16x8*)(lds + PG8_SA(b, h) + aoff + m * 2048 + k * 1024); } while (0)
#define PG8_LDB(dst, b, h) do { _Pragma("unroll") for (int n = 0; n < 2; ++n) _Pragma("unroll") for (int k = 0; k < 2; ++k) dst[n][k] = *(const LAS bf16x8*)(lds + PG8_SB(b, h) + boff + n * 2048 + k * 1024); } while (0)
#define PG8_MMA(ai, bj, At, Bt) do { __builtin_amdgcn_s_setprio(1); _Pragma("unroll") for (int m = 0; m < 4; ++m) _Pragma("unroll") for (int n = 0; n < 2; ++n) _Pragma("unroll") for (int k = 0; k < 2; ++k) \
        acc[ai][bj][m][n] = __builtin_amdgcn_mfma_f32_16x16x32_bf16(Bt[n][k], At[m][k], acc[ai][bj][m][n], 0, 0, 0); __builtin_amdgcn_s_setprio(0); } while (0)
#define PG8_WAIT_V(n) asm volatile("s_waitcnt vmcnt(" #n ")" ::: "memory")
#define PG8_WAIT_L(n) asm volatile("s_waitcnt lgkmcnt(" #n ")" ::: "memory")
#define PG8_BAR __builtin_amdgcn_s_barrier()
#define PG8_SCHED __builtin_amdgcn_sched_barrier(0)
    Unit cur, nxt; int ui = 0;
    if (!S.next(0, cur)) return;
    f32x4 acc[2][2][4][2];
#pragma unroll
    for (int a = 0; a < 2; ++a)
#pragma unroll
        for (int b = 0; b < 2; ++b)
#pragma unroll
            for (int m = 0; m < 4; ++m)
#pragma unroll
                for (int n = 0; n < 2; ++n) acc[a][b][m][n] = (f32x4){0.f, 0.f, 0.f, 0.f};
    bf16x8 At[4][2], B0[2][2], B1[2][2];
    const char* cA = (const char*)g.A + (size_t)cur.pm * tstepA + (size_t)S.a_coloff(cur) * 2; const char* cB = (const char*)g.Bt + (size_t)cur.pn * tstepB;
    PG8_STAGE(PG8_SB(0, 0), cB, voffB); PG8_STAGE(PG8_SA(0, 0), cA, voffA); PG8_STAGE(PG8_SB(0, 1), cB + hstepB, voffB); PG8_STAGE(PG8_SA(0, 1), cA + hstepA, voffA);
    if (wr == 1) PG8_BAR;
    PG8_WAIT_V(4); PG8_BAR;
    PG8_STAGE(PG8_SB(1, 0), cB + kstep, voffB); PG8_STAGE(PG8_SA(1, 0), cA + kstep, voffA); PG8_STAGE(PG8_SB(1, 1), cB + hstepB + kstep, voffB);
    PG8_WAIT_V(6); PG8_BAR;
    for (;;) {
        const bool has_next = S.next(ui + 1, nxt);
        const char* nA = has_next ? (const char*)g.A + (size_t)nxt.pm * tstepA + (size_t)S.a_coloff(nxt) * 2 : cA; const char* nB = has_next ? (const char*)g.Bt + (size_t)nxt.pn * tstepB : cB;
        for (int t = 0; t < nt; t += 2) {
            const bool last = (t == nt - 2);
            const char* a1 = cA + (size_t)(t + 1) * kstep;
            const char* a2 = last ? nA : cA + (size_t)(t + 2) * kstep; const char* b2 = last ? nB : cB + (size_t)(t + 2) * kstep;
            const char* a3 = a2 + kstep; const char* b3 = b2 + kstep;
            PG8_LDB(B0, 0, 0); PG8_SCHED; PG8_LDA(At, 0, 0); PG8_STAGE(PG8_SA(1, 1), a1 + hstepA, voffA);
            PG8_WAIT_L(8); PG8_BAR; PG8_WAIT_L(0); PG8_MMA(0, 0, At, B0); PG8_BAR; PG8_SCHED;
            PG8_LDB(B1, 0, 1); PG8_STAGE(PG8_SB(0, 0), b2, voffB);
            PG8_BAR; PG8_WAIT_L(0); PG8_MMA(0, 1, At, B1); PG8_BAR;
            PG8_LDA(At, 0, 1); PG8_STAGE(PG8_SA(0, 0), a2, voffA);
            PG8_BAR; PG8_WAIT_L(0); PG8_MMA(1, 0, At, B0); PG8_BAR; PG8_SCHED;
            PG8_STAGE(PG8_SB(0, 1), b2 + hstepB, voffB);
            PG8_WAIT_V(6); PG8_BAR; PG8_MMA(1, 1, At, B1); PG8_BAR;
            PG8_LDB(B0, 1, 0); PG8_SCHED; PG8_LDA(At, 1, 0); PG8_STAGE(PG8_SA(0, 1), a2 + hstepA, voffA);
            PG8_WAIT_L(8); PG8_BAR; PG8_WAIT_L(0); PG8_MMA(0, 0, At, B0); PG8_BAR; PG8_SCHED;
            PG8_LDB(B1, 1, 1); PG8_STAGE(PG8_SB(1, 0), b3, voffB);
            PG8_BAR; PG8_WAIT_L(0); PG8_MMA(0, 1, At, B1); PG8_BAR;
            PG8_LDA(At, 1, 1); PG8_STAGE(PG8_SA(1, 0), a3, voffA);
            PG8_BAR; PG8_WAIT_L(0); PG8_MMA(1, 0, At, B0); PG8_BAR; PG8_SCHED;
            PG8_STAGE(PG8_SB(1, 1), b3 + hstepB, voffB);
            PG8_WAIT_V(6); PG8_BAR; PG8_MMA(1, 1, At, B1); PG8_BAR;
        }
        E(acc, cur, wr, wc, fr, fq);
        if (!has_next) break;
#pragma unroll
        for (int a = 0; a < 2; ++a)
#pragma unroll
            for (int b = 0; b < 2; ++b)
#pragma unroll
                for (int m = 0; m < 4; ++m)
#pragma unroll
                    for (int n = 0; n < 2; ++n) acc[a][b][m][n] = (f32x4){0.f, 0.f, 0.f, 0.f};
        cur = nxt; cA = nA; cB = nB; ++ui;
    }
    PG8_WAIT_V(0);
    if (wr == 0) PG8_BAR;
    PG8_BAR;
#undef PG8_SA
#undef PG8_SB
#undef PG8_STAGE
#undef PG8_LDA
#undef PG8_LDB
#undef PG8_MMA
#undef PG8_WAIT_V
#undef PG8_WAIT_L
#undef PG8_BAR
#undef PG8_SCHED
}

struct EpiSwiGLU {
    static constexpr bool PERM = true;
    bf16_t* H;
    __device__ __forceinline__ void operator()(const f32x4 (&acc)[2][2][4][2], const Unit& u, int wr, int wc, int fr, int fq) const {
        const int row0 = u.pm * BM + wr * 64 + fr, col0 = u.pn * 128 + wc * 32 + 8 * fq;
#pragma unroll
        for (int ai = 0; ai < 2; ++ai)
#pragma unroll
            for (int m = 0; m < 4; ++m) {
                bf16_t* rowp = H + (size_t)(row0 + ai * HALF + m * 16) * DFF + col0;
                const f32x4 g0 = acc[ai][0][m][0], g1 = acc[ai][0][m][1], u0 = acc[ai][1][m][0], u1 = acc[ai][1][m][1];
                float v[8];
#pragma unroll
                for (int j = 0; j < 4; ++j) { v[j] = fast_silu(g0[j]) * u0[j]; v[4 + j] = fast_silu(g1[j]) * u1[j]; }
                u32x4 w; w.x = cvt_pk_bf16(v[0], v[1]); w.y = cvt_pk_bf16(v[2], v[3]); w.z = cvt_pk_bf16(v[4], v[5]); w.w = cvt_pk_bf16(v[6], v[7]);
                *(u32x4*)rowp = w;
            }
    }
};
struct EpiResid {
    static constexpr bool PERM = false;
    const float* res; float* Y; float alpha, s;
    __device__ __forceinline__ void operator()(const f32x4 (&acc)[2][2][4][2], const Unit& u, int wr, int wc, int fr, int fq) const {
        const int row0 = u.pm * BM + wr * 64 + fr, col0 = u.pn * BM + wc * 32 + 4 * fq;
#pragma unroll
        for (int ai = 0; ai < 2; ++ai)
#pragma unroll
            for (int m = 0; m < 4; ++m) { const size_t off = (size_t)(row0 + ai * HALF + m * 16) * DM + col0;
#pragma unroll
                for (int bj = 0; bj < 2; ++bj)
#pragma unroll
                    for (int n = 0; n < 2; ++n) { const f32x4 r = *(const f32x4*)(res + off + bj * HALF + n * 16); *(f32x4*)(Y + off + bj * HALF + n * 16) = r * alpha + acc[ai][bj][m][n] * s; }
                asm volatile("" ::: "memory"); }
    }
};
template <int ACT  , int SHIFT_AT  > struct EpiBiasBf16 {
    static constexpr bool PERM = true;
    bf16_t* O; int ldc; const float* bias;
    __device__ __forceinline__ void operator()(const f32x4 (&acc)[2][2][4][2], const Unit& u, int wr, int wc, int fr, int fq) const {
        const int row0 = u.pm * BM + wr * 64 + fr, col0 = u.pn * BM + wc * 32 + 8 * fq;
        f32x4 bv[2][2];
#pragma unroll
        for (int bj = 0; bj < 2; ++bj) { const int c = col0 + bj * HALF; const int bc = c + (c >= SHIFT_AT ? 8 : 0);
            bv[bj][0] = *(const f32x4*)(bias + bc); bv[bj][1] = *(const f32x4*)(bias + bc + 4); }
#pragma unroll
        for (int ai = 0; ai < 2; ++ai)
#pragma unroll
            for (int m = 0; m < 4; ++m) { bf16_t* rowp = O + (size_t)(row0 + ai * HALF + m * 16) * ldc + col0;
#pragma unroll
                for (int bj = 0; bj < 2; ++bj) { f32x4 v0 = acc[ai][bj][m][0] + bv[bj][0], v1 = acc[ai][bj][m][1] + bv[bj][1];
                    if (ACT == 1) {
#pragma unroll
                        for (int j = 0; j < 4; ++j) { v0[j] = fast_sigmoid(v0[j]); v1[j] = fast_sigmoid(v1[j]); } }
                    u32x4 w; w.x = cvt_pk_bf16(v0[0], v0[1]); w.y = cvt_pk_bf16(v0[2], v0[3]); w.z = cvt_pk_bf16(v1[0], v1[1]); w.w = cvt_pk_bf16(v1[2], v1[3]);
                    *(u32x4*)(rowp + bj * HALF) = w; } }
    }
};
struct EpiBranch {
    static constexpr bool PERM = true;
    const bf16_t* gates; bf16_t* MG;
    __device__ __forceinline__ void operator()(const f32x4 (&acc)[2][2][4][2], const Unit& u, int wr, int wc, int fr, int fq) const {
        const int br = u.pn >> 2, pn4 = u.pn & 3;
        const int row0 = u.pm * BM + wr * 64 + fr, col0 = pn4 * BM + wc * 32 + 8 * fq;
#pragma unroll
        for (int ai = 0; ai < 2; ++ai)
#pragma unroll
            for (int m = 0; m < 4; ++m) { const size_t r = (size_t)(row0 + ai * HALF + m * 16);
#pragma unroll
                for (int bj = 0; bj < 2; ++bj) { const int c = col0 + bj * HALF;
                    const u32x4 gw = *(const u32x4*)(gates + r * 3072 + br * 1024 + c);
                    const f32x4 a0 = acc[ai][bj][m][0], a1 = acc[ai][bj][m][1];
                    float v[8];
                    v[0] = bf_lo(gw.x) * a0[0]; v[1] = bf_hi(gw.x) * a0[1]; v[2] = bf_lo(gw.y) * a0[2]; v[3] = bf_hi(gw.y) * a0[3];
                    v[4] = bf_lo(gw.z) * a1[0]; v[5] = bf_hi(gw.z) * a1[1]; v[6] = bf_lo(gw.w) * a1[2]; v[7] = bf_hi(gw.w) * a1[3];
                    if (br > 0) { const u32x4 pw = *(const u32x4*)(MG + r * DM + c);
                        v[0] += bf_lo(pw.x); v[1] += bf_hi(pw.x); v[2] += bf_lo(pw.y); v[3] += bf_hi(pw.y); v[4] += bf_lo(pw.z); v[5] += bf_hi(pw.z); v[6] += bf_lo(pw.w); v[7] += bf_hi(pw.w); }
                    u32x4 w; w.x = cvt_pk_bf16(v[0], v[1]); w.y = cvt_pk_bf16(v[2], v[3]); w.z = cvt_pk_bf16(v[4], v[5]); w.w = cvt_pk_bf16(v[6], v[7]);
                    *(u32x4*)(MG + r * DM + c) = w; }
                asm volatile("" ::: "memory"); }
    }
};
}

struct Params { const float* in[25]; float* out; unsigned char* ws; };
enum { I_X = 0, I_LN1G, I_LN1B, I_FF1IN, I_FF1OUT, I_WIN, I_BIN, I_CONVW, I_ALOG, I_DTB, I_GNG, I_RELB, I_SINKS, I_WGATE, I_BGATE, I_WBRA, I_WBRB, I_WBRC, I_WOUT, I_LN2G, I_LN2B, I_FF2IN, I_FF2OUT, I_LN3G, I_LN3B };

__device__ __forceinline__ float wave_sum(float v) {
#pragma unroll
    for (int o = 32; o >= 1; o >>= 1) v += __shfl_xor(v, o);
    return v;
}

__device__ __forceinline__ int colmap(int kind, int n) {
    if (kind == 1) { const int t = n >> 8, w = n & 255; return (w < 128) ? (t * 128 + w) : (DFF + t * 128 + (w - 128)); }
    if (kind == 2) return n < 1536 ? n : n + 8;
    return n;
}
__device__ __forceinline__ void cv_tiles(float* tile  , bf16_t* dst, int N, int K, const float* src, int ld, int kind, int bid, int nblk) {
    int tid_ = threadIdx.x; asm volatile("" : "+v"(tid_)); const int tid = tid_;
    const int tk = K / 64, ntile = (N / 64) * tk;
    for (int t = bid; t < ntile; t += nblk) {
        const int n0 = (t / tk) * 64, k0 = (t % tk) * 64;
#pragma unroll
        for (int i = 0; i < 8; ++i) { const int e = tid + i * 512, kk = e >> 6, nn = e & 63;
            tile[kk * 65 + nn] = src[(size_t)(k0 + kk) * ld + colmap(kind, n0 + nn)]; }
        __syncthreads();
        { const int nn = tid >> 3, k8 = (tid & 7) * 8; float v[8];
#pragma unroll
          for (int i = 0; i < 8; ++i) v[i] = tile[(k8 + i) * 65 + nn];
          u32x4 w; w.x = cvt_pk_bf16(v[0], v[1]); w.y = cvt_pk_bf16(v[2], v[3]); w.z = cvt_pk_bf16(v[4], v[5]); w.w = cvt_pk_bf16(v[6], v[7]);
          *(u32x4*)(dst + (size_t)(n0 + nn) * K + k0 + k8) = w; }
        __syncthreads();
    }
}

__device__ __forceinline__ void ln_phase(float* ldsf, const float* Y, const float* gam, const float* bet, float* XF, bf16_t* XB,
                         bool do_bg, const float* w_in, const float* b_in, const float* a_log, const float* dt_bias, float* BETA, float* GLOG) {
    int tid_ = threadIdx.x; asm volatile("" : "+v"(tid_)); const int tid = tid_, wv = tid >> 6, l = tid & 63;
    if (do_bg) { for (int e = tid; e < 8192; e += 512) ldsf[e] = w_in[(size_t)(e >> 3) * WIN_LD + 1536 + (e & 7)]; }
    __syncthreads();
    f32x4 gv[4], bv[4];
#pragma unroll
    for (int i = 0; i < 4; ++i) { gv[i] = *(const f32x4*)(gam + i * 256 + l * 4); bv[i] = *(const f32x4*)(bet + i * 256 + l * 4); }
    for (int row = blockIdx.x * 8 + wv; row < M_TOK; row += gridDim.x * 8) {
        f32x4 v[4];
#pragma unroll
        for (int i = 0; i < 4; ++i) v[i] = *(const f32x4*)(Y + (size_t)row * DM + i * 256 + l * 4);
        float s = 0.f;
#pragma unroll
        for (int i = 0; i < 4; ++i) s += (v[i][0] + v[i][1]) + (v[i][2] + v[i][3]);
        const float mean = wave_sum(s) * (1.0f / 1024.0f);
        float q = 0.f;
#pragma unroll
        for (int i = 0; i < 4; ++i) { v[i] = v[i] - mean; q += (v[i][0] * v[i][0] + v[i][1] * v[i][1]) + (v[i][2] * v[i][2] + v[i][3] * v[i][3]); }
        const float rstd = rsqrtf(wave_sum(q) * (1.0f / 1024.0f) + 1e-5f);
#pragma unroll
        for (int i = 0; i < 4; ++i) {
            v[i] = v[i] * rstd * gv[i] + bv[i];
            *(f32x4*)(XF + (size_t)row * DM + i * 256 + l * 4) = v[i];
            u32x2 w; w.x = cvt_pk_bf16(v[i][0], v[i][1]); w.y = cvt_pk_bf16(v[i][2], v[i][3]);
            *(u32x2*)(XB + (size_t)row * DM + i * 256 + l * 4) = w;
        }
        if (do_bg) {
            float d[8];
#pragma unroll
            for (int j = 0; j < 8; ++j) d[j] = 0.f;
#pragma unroll
            for (int i = 0; i < 4; ++i)
#pragma unroll
                for (int jj = 0; jj < 4; ++jj) { const int k = i * 256 + l * 4 + jj; const f32x4 w0 = *(const f32x4*)(ldsf + k * 8), w1 = *(const f32x4*)(ldsf + k * 8 + 4); const float x = v[i][jj];
                    d[0] += x * w0[0]; d[1] += x * w0[1]; d[2] += x * w0[2]; d[3] += x * w0[3]; d[4] += x * w1[0]; d[5] += x * w1[1]; d[6] += x * w1[2]; d[7] += x * w1[3]; }
#pragma unroll
            for (int j = 0; j < 8; ++j) d[j] = wave_sum(d[j]);
            if (l == 0) {
                f32x4 bo, go;
#pragma unroll
                for (int h = 0; h < 4; ++h) {
                    bo[h] = 1.0f / (1.0f + expf(-(d[h] + b_in[1536 + h])));
                    const float xa = d[4 + h] + b_in[1540 + h] + dt_bias[h];
                    const float sp = xa > 20.f ? xa : log1pf(expf(xa));
                    go[h] = -expf(a_log[h]) * sp;
                }
                *(f32x4*)(BETA + (size_t)row * 4) = bo; *(f32x4*)(GLOG + (size_t)row * 4) = go;
            }
        }
    }
}

__device__ __forceinline__ void prep_phase(const bf16_t* PROJ, const float* conv_w, bf16_t* QN, bf16_t* KN, bf16_t* VC) {
    int tid_ = threadIdx.x; asm volatile("" : "+v"(tid_)); const int tid = tid_, wv = tid >> 6, l = tid & 63;
    for (int r = blockIdx.x * 8 + wv; r < M_TOK * 12; r += gridDim.x * 8) {
        const int tok = r / 12, wh = r - tok * 12, which = wh >> 2, h = wh & 3;
        const int ch = which * 512 + h * 128 + 2 * l;
        const int tpos = tok & (SEQ - 1);
        float a0 = 0.f, a1 = 0.f;
#pragma unroll
        for (int i = 0; i < 4; ++i) {
            if (tpos - 3 + i >= 0) {
                const unsigned pv = *(const unsigned*)(PROJ + (size_t)(tok - 3 + i) * PROJ_LD + ch);
                const f32x2 cw = *(const f32x2*)(conv_w + i * 1536 + ch);
                a0 += cw[0] * bf_lo(pv); a1 += cw[1] * bf_hi(pv);
            }
        }
        a0 = a0 / (1.0f + expf(-a0)); a1 = a1 / (1.0f + expf(-a1));
        if (which < 2) {
            const float ss = wave_sum(a0 * a0 + a1 * a1);
            float rs = rsqrtf(ss + 1e-6f);
            if (which == 0) rs *= 0.08838834764831845f;
            a0 *= rs; a1 *= rs;
        }
        bf16_t* dst = which == 0 ? QN : (which == 1 ? KN : VC);
        *(unsigned*)(dst + (size_t)tok * 512 + h * 128 + 2 * l) = cvt_pk_bf16(a0, a1);
    }
}

__device__ __forceinline__ void delta_recurrent(float* ldsf, int bh, bf16_t* PROJ, const bf16_t* QN, const bf16_t* KN, const bf16_t* VC, const float* BETA, const float* GLOG, const float* norm_g) {
    int tid_ = threadIdx.x; asm volatile("" : "+v"(tid_)); const int tid = tid_, wv = tid >> 6, l = tid & 63, c = l & 15, gq = l >> 4;
    const int b = bh >> 2, h = bh & 3;
    float* qs = ldsf; float* ks = ldsf + 8192; float* vs = ldsf + 16384; float* Os = ldsf + 24576; float* al = ldsf + 32768; float* be = al + 64;
    float s[32];
#pragma unroll
    for (int i = 0; i < 32; ++i) s[i] = 0.f;
    for (int n = 0; n < NCHUNK; ++n) {
        const size_t row0 = (size_t)b * SEQ + n * 64;
        __syncthreads();
#pragma unroll
        for (int it = 0; it < 2; ++it) { const int e = tid + it * 512, t = e >> 4, p8 = (e & 15) * 8;
            const size_t g = (row0 + t) * 512 + h * 128 + p8;
            const u32x4 qw = *(const u32x4*)(QN + g), kw = *(const u32x4*)(KN + g), vw = *(const u32x4*)(VC + g);
            float* qd = qs + t * 128 + p8; float* kd = ks + t * 128 + p8; float* vd = vs + t * 128 + p8;
            *(f32x4*)qd = (f32x4){bf_lo(qw.x), bf_hi(qw.x), bf_lo(qw.y), bf_hi(qw.y)}; *(f32x4*)(qd + 4) = (f32x4){bf_lo(qw.z), bf_hi(qw.z), bf_lo(qw.w), bf_hi(qw.w)};
            *(f32x4*)kd = (f32x4){bf_lo(kw.x), bf_hi(kw.x), bf_lo(kw.y), bf_hi(kw.y)}; *(f32x4*)(kd + 4) = (f32x4){bf_lo(kw.z), bf_hi(kw.z), bf_lo(kw.w), bf_hi(kw.w)};
            *(f32x4*)vd = (f32x4){bf_lo(vw.x), bf_hi(vw.x), bf_lo(vw.y), bf_hi(vw.y)}; *(f32x4*)(vd + 4) = (f32x4){bf_lo(vw.z), bf_hi(vw.z), bf_lo(vw.w), bf_hi(vw.w)};
        }
        if (tid < 64) { al[tid] = expf(GLOG[(row0 + tid) * 4 + h]); be[tid] = BETA[(row0 + tid) * 4 + h]; }
        __syncthreads();
        for (int t = 0; t < 64; ++t) {
            const float a = al[t], bt = be[t];
            float kk[32], qq[32];
#pragma unroll
            for (int i = 0; i < 8; ++i) { const f32x4 kv = *(const f32x4*)(ks + t * 128 + gq * 32 + i * 4); kk[4 * i] = kv[0]; kk[4 * i + 1] = kv[1]; kk[4 * i + 2] = kv[2]; kk[4 * i + 3] = kv[3];
                                          const f32x4 qv = *(const f32x4*)(qs + t * 128 + gq * 32 + i * 4); qq[4 * i] = qv[0]; qq[4 * i + 1] = qv[1]; qq[4 * i + 2] = qv[2]; qq[4 * i + 3] = qv[3]; }
            float k0 = 0.f, k1 = 0.f, k2 = 0.f, k3 = 0.f;
#pragma unroll
            for (int i = 0; i < 32; i += 4) { k0 += kk[i] * s[i]; k1 += kk[i + 1] * s[i + 1]; k2 += kk[i + 2] * s[i + 2]; k3 += kk[i + 3] * s[i + 3]; }
            float ksum = (k0 + k1) + (k2 + k3);
            ksum += __shfl_xor(ksum, 16); ksum += __shfl_xor(ksum, 32);
            const float vn = bt * (vs[t * 128 + wv * 16 + c] - a * ksum);
#pragma unroll
            for (int i = 0; i < 32; ++i) s[i] = a * s[i] + kk[i] * vn;
            float o0 = 0.f, o1 = 0.f, o2 = 0.f, o3 = 0.f;
#pragma unroll
            for (int i = 0; i < 32; i += 4) { o0 += qq[i] * s[i]; o1 += qq[i + 1] * s[i + 1]; o2 += qq[i + 2] * s[i + 2]; o3 += qq[i + 3] * s[i + 3]; }
            float os = (o0 + o1) + (o2 + o3);
            os += __shfl_xor(os, 16); os += __shfl_xor(os, 32);
            if (gq == 0) Os[t * 128 + wv * 16 + c] = os;
        }
        __syncthreads();
        {
            const int t = tid >> 3, j8 = tid & 7;
            float o[16]; float ss = 0.f;
#pragma unroll
            for (int i = 0; i < 4; ++i) { const f32x4 ov = *(const f32x4*)(Os + t * 128 + j8 * 16 + i * 4); o[4 * i] = ov[0]; o[4 * i + 1] = ov[1]; o[4 * i + 2] = ov[2]; o[4 * i + 3] = ov[3]; }
#pragma unroll
            for (int i = 0; i < 16; ++i) ss += o[i] * o[i];
            ss += __shfl_xor(ss, 1); ss += __shfl_xor(ss, 2); ss += __shfl_xor(ss, 4);
            const float rs = rsqrtf(ss * (1.0f / 128.0f) + 1e-6f);
            bf16_t* prow = PROJ + (row0 + t) * PROJ_LD + h * 128 + j8 * 16;
            const u32x4 z0 = *(const u32x4*)(prow + C_ZA), z1 = *(const u32x4*)(prow + C_ZA + 8);
            const unsigned zw[8] = {z0.x, z0.y, z0.z, z0.w, z1.x, z1.y, z1.z, z1.w};
            unsigned ow[8];
#pragma unroll
            for (int i = 0; i < 8; ++i) {
                const float za = bf_lo(zw[i]), zb = bf_hi(zw[i]);
                const float ra = o[2 * i] * rs * norm_g[j8 * 16 + 2 * i] * (za / (1.0f + expf(-za)));
                const float rb = o[2 * i + 1] * rs * norm_g[j8 * 16 + 2 * i + 1] * (zb / (1.0f + expf(-zb)));
                ow[i] = cvt_pk_bf16(ra, rb);
            }
            *(u32x4*)(prow + C_QA) = (u32x4){ow[0], ow[1], ow[2], ow[3]}; *(u32x4*)(prow + C_QA + 8) = (u32x4){ow[4], ow[5], ow[6], ow[7]};
        }
    }
}


#define DPP_ADD(x, CTRL) ((x) + __int_as_float(__builtin_amdgcn_update_dpp(0, __float_as_int(x), CTRL, 0xF, 0xF, true)))
#define ROW16_SUM(x) do { x = DPP_ADD(x, 0xB1); x = DPP_ADD(x, 0x4E); x = DPP_ADD(x, 0x124); x = DPP_ADD(x, 0x128); } while (0)
__device__ __forceinline__ void delta_recurrent4(float* ldsf, int u, const bf16_t* QN, const bf16_t* KN, const bf16_t* VC, const float* BETA, const float* GLOG, float* ORAW) {
    int tid_ = threadIdx.x; asm volatile("" : "+v"(tid_)); const int tid = tid_, wv = tid >> 6, l = tid & 63, c = l >> 4, gq = l & 15;
    const int bh = u >> 2, qd = u & 3, b = bh >> 2, h = bh & 3;
    float* qs = ldsf; float* ks = ldsf + 8192; float* vs = ldsf + 16384; float* al = ldsf + 16384 + 2048; float* be = al + 64;
    float s[8];
#pragma unroll
    for (int i = 0; i < 8; ++i) s[i] = 0.f;
    const int dvc = qd * 32 + wv * 4 + c;
    for (int n = 0; n < NCHUNK; ++n) {
        const size_t row0 = (size_t)b * SEQ + n * 64;
        __syncthreads();
#pragma unroll
        for (int it = 0; it < 2; ++it) { const int e = tid + it * 512, t = e >> 4, p8 = (e & 15) * 8;
            const size_t g = (row0 + t) * 512 + h * 128 + p8;
            const u32x4 qw = *(const u32x4*)(QN + g), kw = *(const u32x4*)(KN + g);
            float* qd_ = qs + t * 128 + p8; float* kd = ks + t * 128 + p8;
            *(f32x4*)qd_ = (f32x4){bf_lo(qw.x), bf_hi(qw.x), bf_lo(qw.y), bf_hi(qw.y)}; *(f32x4*)(qd_ + 4) = (f32x4){bf_lo(qw.z), bf_hi(qw.z), bf_lo(qw.w), bf_hi(qw.w)};
            *(f32x4*)kd = (f32x4){bf_lo(kw.x), bf_hi(kw.x), bf_lo(kw.y), bf_hi(kw.y)}; *(f32x4*)(kd + 4) = (f32x4){bf_lo(kw.z), bf_hi(kw.z), bf_lo(kw.w), bf_hi(kw.w)};
        }
        if (tid < 256) { const int t = tid >> 2, p8 = (tid & 3) * 8;
            const u32x4 vw = *(const u32x4*)(VC + (row0 + t) * 512 + h * 128 + qd * 32 + p8);
            float* vd = vs + t * 32 + p8;
            *(f32x4*)vd = (f32x4){bf_lo(vw.x), bf_hi(vw.x), bf_lo(vw.y), bf_hi(vw.y)}; *(f32x4*)(vd + 4) = (f32x4){bf_lo(vw.z), bf_hi(vw.z), bf_lo(vw.w), bf_hi(vw.w)};
        }
        if (tid < 64) { al[tid] = expf(GLOG[(row0 + tid) * 4 + h]); be[tid] = BETA[(row0 + tid) * 4 + h]; }
        __syncthreads();
        for (int t = 0; t < 64; ++t) {
            const float a = al[t], bt = be[t];
            const f32x4 k0 = *(const f32x4*)(ks + t * 128 + gq * 8), k1 = *(const f32x4*)(ks + t * 128 + gq * 8 + 4);
            const f32x4 q0 = *(const f32x4*)(qs + t * 128 + gq * 8), q1 = *(const f32x4*)(qs + t * 128 + gq * 8 + 4);
            float ksum = ((k0[0] * s[0] + k0[1] * s[1]) + (k0[2] * s[2] + k0[3] * s[3])) + ((k1[0] * s[4] + k1[1] * s[5]) + (k1[2] * s[6] + k1[3] * s[7]));
            ROW16_SUM(ksum);
            const float vn = bt * (vs[t * 32 + wv * 4 + c] - a * ksum);
            s[0] = a * s[0] + k0[0] * vn; s[1] = a * s[1] + k0[1] * vn; s[2] = a * s[2] + k0[2] * vn; s[3] = a * s[3] + k0[3] * vn;
            s[4] = a * s[4] + k1[0] * vn; s[5] = a * s[5] + k1[1] * vn; s[6] = a * s[6] + k1[2] * vn; s[7] = a * s[7] + k1[3] * vn;
            float os = ((q0[0] * s[0] + q0[1] * s[1]) + (q0[2] * s[2] + q0[3] * s[3])) + ((q1[0] * s[4] + q1[1] * s[5]) + (q1[2] * s[6] + q1[3] * s[7]));
            ROW16_SUM(os);
            if (gq == 0) ORAW[(row0 + t) * 512 + h * 128 + dvc] = os;
        }
    }
}
__device__ __forceinline__ void delta_norm_phase(const float* ORAW, bf16_t* PROJ, const float* norm_g) {
    int tid_ = threadIdx.x; asm volatile("" : "+v"(tid_)); const int tid = tid_, wv = tid >> 6, l = tid & 63;
    const f32x2 ng = *(const f32x2*)(norm_g + 2 * l);
    for (int r = blockIdx.x * 8 + wv; r < M_TOK * 4; r += gridDim.x * 8) {
        const int tok = r >> 2, h = r & 3;
        const f32x2 o = *(const f32x2*)(ORAW + (size_t)tok * 512 + h * 128 + 2 * l);
        const float ss = wave_sum(o[0] * o[0] + o[1] * o[1]);
        const float rs = rsqrtf(ss * (1.0f / 128.0f) + 1e-6f);
        bf16_t* prow = PROJ + (size_t)tok * PROJ_LD + h * 128 + 2 * l;
        const unsigned zw = *(const unsigned*)(prow + C_ZA);
        const float za = bf_lo(zw), zb = bf_hi(zw);
        *(unsigned*)(prow + C_QA) = cvt_pk_bf16(o[0] * rs * ng[0] * (za / (1.0f + expf(-za))), o[1] * rs * ng[1] * (zb / (1.0f + expf(-zb))));
    }
}
template <int D, bool MODE_C>
__device__ __forceinline__ void attn_half(unsigned char* hl, bf16_t* PROJ, int b, int n, int qcol, int kcol, int vcol, const float* rb, float slope, float sink, int htid) {
    constexpr int NPREV = MODE_C ? 2 : 8;
    constexpr int KP = D + 8;
    bf16_t* Ks = (bf16_t*)hl; bf16_t* Vt = (bf16_t*)(hl + 64 * KP * 2); float* rbs = (float*)(hl + 64 * KP * 2 + D * 72 * 2);
    const int w4 = htid >> 6, l = htid & 63, lr = l & 15, lg = l >> 4, q0 = w4 * 16;
    const float scale = MODE_C ? 0.125f : 0.08838834764831845f;
    const size_t qrow = (size_t)b * SEQ + n * 64 + q0 + lr;
    bf16x8 qf[D / 32];
#pragma unroll
    for (int ks = 0; ks < D / 32; ++ks) qf[ks] = *(const bf16x8*)(PROJ + qrow * PROJ_LD + qcol + ks * 32 + lg * 8);
    if (!MODE_C) { if (htid < 192) rbs[htid] = rb[htid]; }
    f32x4 o[D / 16];
#pragma unroll
    for (int i = 0; i < D / 16; ++i) o[i] = (f32x4){0.f, 0.f, 0.f, 0.f};
    float mrun = -1e30f, lsum = 0.f;
    const int kc0 = n - NPREV < 0 ? 0 : n - NPREV;
    for (int kc = kc0; kc <= n; ++kc) {
        __syncthreads();
        const size_t krow0 = (size_t)b * SEQ + kc * 64;
#pragma unroll
        for (int it = 0; it < (64 * (D / 8)) / 256; ++it) {
            const int e = htid + it * 256, r = e / (D / 8), p8 = e % (D / 8);
            *(u32x4*)(Ks + r * KP + p8 * 8) = *(const u32x4*)(PROJ + (krow0 + r) * PROJ_LD + kcol + p8 * 8);
        }
#pragma unroll
        for (int it = 0; it < (64 * (D / 8)) / 256; ++it) {
            const int e = htid + it * 256, r = e & 63, p8 = e >> 6;
            const u32x4 vw = *(const u32x4*)(PROJ + (krow0 + r) * PROJ_LD + vcol + p8 * 8);
            bf16_t* vd = Vt + (p8 * 8) * 72 + r;
            vd[0] = (bf16_t)(vw.x & 0xffff); vd[72] = (bf16_t)(vw.x >> 16); vd[144] = (bf16_t)(vw.y & 0xffff); vd[216] = (bf16_t)(vw.y >> 16);
            vd[288] = (bf16_t)(vw.z & 0xffff); vd[360] = (bf16_t)(vw.z >> 16); vd[432] = (bf16_t)(vw.w & 0xffff); vd[504] = (bf16_t)(vw.w >> 16);
        }
        __syncthreads();
        f32x4 st[4];
#pragma unroll
        for (int kt = 0; kt < 4; ++kt) {
            st[kt] = (f32x4){0.f, 0.f, 0.f, 0.f};
#pragma unroll
            for (int ks = 0; ks < D / 32; ++ks) {
                const bf16x8 a = *(const bf16x8*)(Ks + (kt * 16 + lr) * KP + ks * 32 + lg * 8);
                st[kt] = __builtin_amdgcn_mfma_f32_16x16x32_bf16(a, qf[ks], st[kt], 0, 0, 0);
            }
        }
        const int dbase = (n - kc) * 64 + q0 + lr;
        float mc = -1e30f;
#pragma unroll
        for (int kt = 0; kt < 4; ++kt)
#pragma unroll
            for (int j = 0; j < 4; ++j) {
                const int dist = dbase - (kt * 16 + lg * 4 + j);
                float sv;
                if (MODE_C) sv = st[kt][j] * scale - slope * fabsf((float)dist);
                else { const int idx = (dist > 128 ? 128 : dist) + 63; sv = st[kt][j] * scale + rbs[idx]; }
                st[kt][j] = sv; mc = fmaxf(mc, sv);
            }
        mc = fmaxf(mc, __shfl_xor(mc, 16)); mc = fmaxf(mc, __shfl_xor(mc, 32));
        const float mnew = fmaxf(mrun, mc), corr = __expf(mrun - mnew);
        mrun = mnew;
        float ps = 0.f;
#pragma unroll
        for (int kt = 0; kt < 4; ++kt)
#pragma unroll
            for (int j = 0; j < 4; ++j) { const float p = __expf(st[kt][j] - mnew); st[kt][j] = p; ps += p; }
        lsum = lsum * corr + ps;
#pragma unroll
        for (int i = 0; i < D / 16; ++i) o[i] = o[i] * corr;
        bf16x8 pb[2];
#pragma unroll
        for (int k2 = 0; k2 < 2; ++k2) {
            u32x4 w; w.x = cvt_pk_bf16(st[2 * k2][0], st[2 * k2][1]); w.y = cvt_pk_bf16(st[2 * k2][2], st[2 * k2][3]);
            w.z = cvt_pk_bf16(st[2 * k2 + 1][0], st[2 * k2 + 1][1]); w.w = cvt_pk_bf16(st[2 * k2 + 1][2], st[2 * k2 + 1][3]);
            pb[k2] = __builtin_bit_cast(bf16x8, w);
        }
#pragma unroll
        for (int dt = 0; dt < D / 16; ++dt)
#pragma unroll
            for (int k2 = 0; k2 < 2; ++k2) {
                const bf16_t* vp = Vt + (dt * 16 + lr) * 72 + lg * 4;
                const u32x2 lo = *(const u32x2*)(vp + (2 * k2) * 16), hi = *(const u32x2*)(vp + (2 * k2 + 1) * 16);
                const u32x4 aw = (u32x4){lo.x, lo.y, hi.x, hi.y};
                o[dt] = __builtin_amdgcn_mfma_f32_16x16x32_bf16(__builtin_bit_cast(bf16x8, aw), pb[k2], o[dt], 0, 0, 0);
            }
    }
    lsum += __shfl_xor(lsum, 16); lsum += __shfl_xor(lsum, 32);
    if (MODE_C) lsum += __expf(sink - mrun);
    const float inv = 1.0f / lsum;
    bf16_t* orow = PROJ + qrow * PROJ_LD + qcol + lg * 4;
#pragma unroll
    for (int dt = 0; dt < D / 16; ++dt) {
        u32x2 w; w.x = cvt_pk_bf16(o[dt][0] * inv, o[dt][1] * inv); w.y = cvt_pk_bf16(o[dt][2] * inv, o[dt][3] * inv);
        *(u32x2*)(orow + dt * 16) = w;
    }
}
constexpr int ATT_HALF_BYTES = 40960;
__device__ __forceinline__ void attn_item(unsigned char* lds, int it, bf16_t* PROJ, const float* rel_bias, const float* sinks) {
    int tid_ = threadIdx.x; asm volatile("" : "+v"(tid_)); const int tid = tid_, half = tid >> 8, htid = tid & 255;
    unsigned char* hl = lds + half * ATT_HALF_BYTES;
    if (it < 512) {
        const int b = it >> 6, n = (it >> 1) & 31, h = (it & 1) * 2 + half;
        attn_half<128, false>(hl, PROJ, b, n, C_QB + h * 128, C_KB + h * 128, C_VB + h * 128, rel_bias + h * 192, 0.f, 0.f, htid);
    } else {
        const int i2 = it - 512, b = i2 >> 7, n = (i2 >> 2) & 31, hq = (i2 & 3) * 2 + half, hkv = hq >> 2;
        const float slope = exp2f(-(float)(hq + 1));
        attn_half<64, true>(hl, PROJ, b, n, C_QC + hq * 64, C_KC + hkv * 64, C_VC + hkv * 64, nullptr, slope, sinks[hq], htid);
    }
}

constexpr int LDS_BYTES = 135168;
constexpr int SCAN_BLOCKS = 128;

__device__ __forceinline__ const Params* get_pp() {
    const unsigned char* ka = (const unsigned char*)__builtin_amdgcn_kernarg_segment_ptr(); asm volatile("" : "+s"(ka)); return (const Params*)ka;
}
#define WSPTR(T, off) ((T*)(ws + (off)))
#define PH_BEGIN const Params* pp = get_pp(); unsigned char* ws = pp->ws; (void)ws; int G = G0, bid = bid0; asm volatile("" : "+s"(G), "+s"(bid));

template <int l>
__device__ __forceinline__ void layer_body(cg::grid_group& grid, const int G0, const int bid0, unsigned char* lds, LAS unsigned char* ldsl, float* ldsf, const float alpha) {
        { PH_BEGIN
          pg8::Gemm g{WSPTR(bf16_t, WS_XB), WSPTR(bf16_t, WS_SLOTA), M_TOK, 8192, DM, DM, DM}; pg8::StaticOrder S; S.init(M_TOK, 8192, G, bid); pg8::EpiSwiGLU E{WSPTR(bf16_t, WS_H)};
          pg8::gemm_phase(ldsl, g, S, E); }
        grid.sync();
        { PH_BEGIN
          pg8::Gemm g{WSPTR(bf16_t, WS_H), WSPTR(bf16_t, WS_SLOTB), M_TOK, DM, DFF, DFF, DFF}; pg8::StaticOrder S; S.init(M_TOK, DM, G, bid);
          pg8::EpiResid E{l == 0 ? pp->in[I_X] : (const float*)pp->out, WSPTR(float, WS_YFFN), alpha, 0.5f};
          pg8::gemm_phase(ldsl, g, S, E); }
        grid.sync();
        { PH_BEGIN
          const float* w_in = pp->in[I_WIN] + (size_t)l * DM * WIN_LD;
          cv_tiles(ldsf, WSPTR(bf16_t, WS_SLOTA), PROJ_LD, DM, w_in, WIN_LD, 2, bid, G);
          cv_tiles(ldsf, WSPTR(bf16_t, WS_SLOTB + SB_WGATE), 3072, DM, pp->in[I_WGATE] + (size_t)l * DM * 3072, 3072, 0, bid, G);
          cv_tiles(ldsf, WSPTR(bf16_t, WS_SLOTB + SB_WBR), 1024, 512, pp->in[I_WBRA] + (size_t)l * 512 * DM, DM, 0, bid, G);
          cv_tiles(ldsf, WSPTR(bf16_t, WS_SLOTB + SB_WBR) + 1024 * 512, 1024, 512, pp->in[I_WBRB] + (size_t)l * 512 * DM, DM, 0, bid, G);
          cv_tiles(ldsf, WSPTR(bf16_t, WS_SLOTB + SB_WBR) + 2048 * 512, 1024, 512, pp->in[I_WBRC] + (size_t)l * 512 * DM, DM, 0, bid, G);
          cv_tiles(ldsf, WSPTR(bf16_t, WS_SLOTB + SB_WOUT), DM, DM, pp->in[I_WOUT] + (size_t)l * DM * DM, DM, 0, bid, G);
          ln_phase(ldsf, WSPTR(float, WS_YFFN), pp->in[I_LN1G] + l * DM, pp->in[I_LN1B] + l * DM, pp->out, WSPTR(bf16_t, WS_XB), true, w_in, pp->in[I_BIN] + (size_t)l * WIN_LD,
                   pp->in[I_ALOG] + l * 4, pp->in[I_DTB] + l * 4, WSPTR(float, WS_BETA), WSPTR(float, WS_GLOG)); }
        grid.sync();
        { PH_BEGIN
          pg8::Gemm g{WSPTR(bf16_t, WS_XB), WSPTR(bf16_t, WS_SLOTA), M_TOK, PROJ_LD, DM, DM, DM}; pg8::StaticOrder S; S.init(M_TOK, PROJ_LD, G, bid);
          pg8::EpiBiasBf16<0, 1536> E{WSPTR(bf16_t, WS_PROJ), PROJ_LD, pp->in[I_BIN] + (size_t)l * WIN_LD};
          pg8::gemm_phase(ldsl, g, S, E); }
        grid.sync();
        { PH_BEGIN
          prep_phase(WSPTR(bf16_t, WS_PROJ), pp->in[I_CONVW] + (size_t)l * 4 * 1536, WSPTR(bf16_t, WS_QN), WSPTR(bf16_t, WS_KN), WSPTR(bf16_t, WS_VC)); }
        grid.sync();
        { PH_BEGIN
          if (bid < SCAN_BLOCKS) delta_recurrent4(ldsf, bid, WSPTR(bf16_t, WS_QN), WSPTR(bf16_t, WS_KN), WSPTR(bf16_t, WS_VC), WSPTR(float, WS_BETA), WSPTR(float, WS_GLOG), WSPTR(float, WS_MERGED));
          else { const float* relb = pp->in[I_RELB] + l * 4 * 192; const float* sinks = pp->in[I_SINKS] + l * 8;
                 for (int it = bid - SCAN_BLOCKS; it < 1536; it += G - SCAN_BLOCKS) attn_item(lds, it, WSPTR(bf16_t, WS_PROJ), relb, sinks); } }
        grid.sync();
        { PH_BEGIN delta_norm_phase(WSPTR(float, WS_MERGED), WSPTR(bf16_t, WS_PROJ), pp->in[I_GNG] + l * 128); __syncthreads(); }
        { PH_BEGIN
          pg8::Gemm g{WSPTR(bf16_t, WS_XB), WSPTR(bf16_t, WS_SLOTB + SB_WGATE), M_TOK, 3072, DM, DM, DM}; pg8::StaticOrder S; S.init(M_TOK, 3072, G, bid);
          pg8::EpiBiasBf16<1, (1 << 30)> E{WSPTR(bf16_t, WS_GATES), 3072, pp->in[I_BGATE] + (size_t)l * 3072};
          pg8::gemm_phase(ldsl, g, S, E); }
        grid.sync();
        { PH_BEGIN
          pg8::Gemm g{WSPTR(bf16_t, WS_PROJ), WSPTR(bf16_t, WS_SLOTB + SB_WBR), M_TOK, 3072, 512, PROJ_LD, 512}; pg8::BranchOrder S{G, bid}; pg8::EpiBranch E{WSPTR(bf16_t, WS_GATES), WSPTR(bf16_t, WS_MERGED)};
          pg8::gemm_phase(ldsl, g, S, E); }
        grid.sync();
        { PH_BEGIN
          pg8::Gemm g{WSPTR(bf16_t, WS_MERGED), WSPTR(bf16_t, WS_SLOTB + SB_WOUT), M_TOK, DM, DM, DM, DM}; pg8::StaticOrder S; S.init(M_TOK, DM, G, bid);
          pg8::EpiResid E{(const float*)pp->out, WSPTR(float, WS_YMIX), alpha, 1.0f};
          pg8::gemm_phase(ldsl, g, S, E); }
        grid.sync();
        { PH_BEGIN
          cv_tiles(ldsf, WSPTR(bf16_t, WS_SLOTA), 8192, DM, pp->in[I_FF2IN] + (size_t)l * DM * 8192, 8192, 1, bid, G);
          cv_tiles(ldsf, WSPTR(bf16_t, WS_SLOTB), DM, DFF, pp->in[I_FF2OUT] + (size_t)l * DFF * DM, DM, 0, bid, G);
          ln_phase(ldsf, WSPTR(float, WS_YMIX), pp->in[I_LN2G] + l * DM, pp->in[I_LN2B] + l * DM, pp->out, WSPTR(bf16_t, WS_XB), false, nullptr, nullptr, nullptr, nullptr, nullptr, nullptr); }
        grid.sync();
        { PH_BEGIN
          pg8::Gemm g{WSPTR(bf16_t, WS_XB), WSPTR(bf16_t, WS_SLOTA), M_TOK, 8192, DM, DM, DM}; pg8::StaticOrder S; S.init(M_TOK, 8192, G, bid); pg8::EpiSwiGLU E{WSPTR(bf16_t, WS_H)};
          pg8::gemm_phase(ldsl, g, S, E); }
        grid.sync();
        { PH_BEGIN
          pg8::Gemm g{WSPTR(bf16_t, WS_H), WSPTR(bf16_t, WS_SLOTB), M_TOK, DM, DFF, DFF, DFF}; pg8::StaticOrder S; S.init(M_TOK, DM, G, bid);
          pg8::EpiResid E{(const float*)pp->out, WSPTR(float, WS_YFFN), alpha, 0.5f};
          pg8::gemm_phase(ldsl, g, S, E); }
        grid.sync();
        { PH_BEGIN
          if (l == 0) {
              cv_tiles(ldsf, WSPTR(bf16_t, WS_SLOTA), 8192, DM, pp->in[I_FF1IN] + (size_t)DM * 8192, 8192, 1, bid, G);
              cv_tiles(ldsf, WSPTR(bf16_t, WS_SLOTB), DM, DFF, pp->in[I_FF1OUT] + (size_t)DFF * DM, DM, 0, bid, G);
          }
          ln_phase(ldsf, WSPTR(float, WS_YFFN), pp->in[I_LN3G] + l * DM, pp->in[I_LN3B] + l * DM, pp->out, WSPTR(bf16_t, WS_XB), false, nullptr, nullptr, nullptr, nullptr, nullptr, nullptr); }
        if (l == 0) grid.sync();
}

__global__ void __launch_bounds__(512, 2) fwd_kernel(Params p_unused) {
    extern __shared__ __attribute__((aligned(16))) unsigned char lds[];
    cg::grid_group grid = cg::this_grid();
    const int G0 = gridDim.x, bid0 = blockIdx.x;
    LAS unsigned char* ldsl = (LAS unsigned char*)lds; float* ldsf = (float*)lds;
    const float alpha = 1.41421356237309515f;

    { PH_BEGIN
      cv_tiles(ldsf, WSPTR(bf16_t, WS_SLOTA), 8192, DM, pp->in[I_FF1IN], 8192, 1, bid, G);
      cv_tiles(ldsf, WSPTR(bf16_t, WS_SLOTB), DM, DFF, pp->in[I_FF1OUT], DM, 0, bid, G);
      const float* x = pp->in[I_X]; bf16_t* XB = WSPTR(bf16_t, WS_XB);
      const int tid = threadIdx.x;
      for (size_t i = ((size_t)bid * 512 + tid) * 4; i < (size_t)M_TOK * DM; i += (size_t)G * 512 * 4) {
          const f32x4 v = *(const f32x4*)(x + i); u32x2 w; w.x = cvt_pk_bf16(v[0], v[1]); w.y = cvt_pk_bf16(v[2], v[3]); *(u32x2*)(XB + i) = w; } }
    grid.sync();

    layer_body<0>(grid, G0, bid0, lds, ldsl, ldsf, alpha);
    layer_body<1>(grid, G0, bid0, lds, ldsl, ldsf, alpha);
}


extern "C" void kernel_launch(void* const* d_in, const int* in_sizes, int n_in, void* d_out, int out_size, void* d_ws, size_t ws_size, hipStream_t stream) {
    static int grid_blocks = 0;
    if (!grid_blocks) {
        int dev = 0, cus = 0, per_cu = 0;
        (void)hipGetDevice(&dev);
        (void)hipDeviceGetAttribute(&cus, hipDeviceAttributeMultiprocessorCount, dev);
        if (hipFuncSetAttribute((const void*)fwd_kernel, hipFuncAttributeMaxDynamicSharedMemorySize, LDS_BYTES) != hipSuccess) fprintf(stderr, "kernel_launch: hipFuncSetAttribute failed\n");
        if (hipOccupancyMaxActiveBlocksPerMultiprocessor(&per_cu, (const void*)fwd_kernel, 512, LDS_BYTES) != hipSuccess || per_cu < 1) { fprintf(stderr, "kernel_launch: occupancy query says %d\n", per_cu); per_cu = 1; }
        (void)hipGetLastError();
        grid_blocks = cus * per_cu;
        if (grid_blocks > 256) grid_blocks = 256;
        if (ws_size < WS_END || n_in != 25) fprintf(stderr, "kernel_launch: workspace %zu < %zu or n_in %d != 25\n", ws_size, (size_t)WS_END, n_in);
        fprintf(stderr, "kernel_launch: grid %d (cus %d x %d), ws %zu\n", grid_blocks, cus, per_cu, ws_size);
    }
    Params p{};
    for (int i = 0; i < 25; ++i) p.in[i] = (const float*)d_in[i];
    p.out = (float*)d_out; p.ws = (unsigned char*)d_ws;
    void* args[] = {&p};
    hipError_t e = hipLaunchCooperativeKernel((const void*)fwd_kernel, dim3(grid_blocks), dim3(512), args, LDS_BYTES, stream);
    if (e != hipSuccess) fprintf(stderr, "cooperative launch failed: %s (grid %d)\n", hipGetErrorString(e), grid_blocks);
}
```

```cpp
#include <hip/hip_runtime.h>
#include <hip/hip_cooperative_groups.h>
#include <cstdio>
namespace cg = cooperative_groups;

#define LAS __attribute__((address_space(3)))
typedef unsigned short bf16_t;
typedef short bf16x8 __attribute__((ext_vector_type(8)));
typedef float f32x4 __attribute__((ext_vector_type(4)));
typedef float f32x2 __attribute__((ext_vector_type(2)));
typedef unsigned u32x4 __attribute__((ext_vector_type(4)));
typedef unsigned u32x2 __attribute__((ext_vector_type(2)));

constexpr int M_TOK = 16384, DM = 1024, DFF = 4096, SEQ = 2048, NCHUNK = 32;
constexpr int PROJ_LD = 4352;
constexpr int C_QA = 0, C_KA = 512, C_VA = 1024, C_ZA = 1536, C_QB = 2048, C_KB = 2560, C_VB = 3072, C_QC = 3584, C_KC = 4096, C_VC = 4224;
constexpr int WIN_LD = 4360;
constexpr size_t MiB = 1ull << 20;
constexpr size_t WS_SLOTA = 0, WS_SLOTB = 16 * MiB, WS_XB = 32 * MiB, WS_R = 64 * MiB;
constexpr size_t WS_H = WS_R, WS_YFFN = WS_R + 128 * MiB;
constexpr size_t WS_PROJ = WS_R, WS_YMIX = WS_R;
constexpr size_t WS_R2 = WS_R + 136 * MiB;
constexpr size_t WS_QN = WS_R2, WS_KN = WS_R2 + 16 * MiB, WS_VC = WS_R2 + 32 * MiB;
constexpr size_t WS_GATES = WS_R2;
constexpr size_t WS_MERGED = WS_R2 + 96 * MiB;
constexpr size_t WS_BETA = WS_R2 + 128 * MiB, WS_GLOG = WS_BETA + 256 * 1024;
constexpr size_t WS_END = WS_GLOG + 256 * 1024;
constexpr size_t SB_WGATE = 0, SB_WBR = 6 * MiB, SB_WOUT = 9 * MiB;

typedef __bf16 bf16x2_n __attribute__((ext_vector_type(2)));
__device__ __forceinline__ unsigned cvt_pk_bf16(float lo, float hi) { const f32x2 v = {lo, hi}; const bf16x2_n b = __builtin_convertvector(v, bf16x2_n); return __builtin_bit_cast(unsigned, b); }
__device__ __forceinline__ float bf_lo(unsigned w) { return __uint_as_float(w << 16); }
__device__ __forceinline__ float bf_hi(unsigned w) { return __uint_as_float(w & 0xffff0000u); }
__device__ __forceinline__ float bf2f(bf16_t b) { return __uint_as_float(((unsigned)b) << 16); }
__device__ __forceinline__ float fast_sigmoid(float x) { return __builtin_amdgcn_rcpf(1.0f + __expf(-x)); }
__device__ __forceinline__ float fast_silu(float x) { return x * fast_sigmoid(x); }

namespace pg8 {
constexpr int BM = 256, BK = 64, HALF = 128, HTB = HALF * BK * 2  , STAGE_BYTES = 8 * HTB, NXCD = 8, WGM = 8;

__host__ __device__ __forceinline__ int lds_byte(int r, int c) { const int st = (r >> 4) * 2 + (c >> 5), rr = r & 15, cc = c & 31, ob = rr * 64 + cc * 2; return st * 1024 + (ob ^ (((ob >> 9) & 1) << 5)); }
__host__ __device__ __forceinline__ void stage_rc(int b, int& R, int& C) { const int st = b / 1024, sb = b % 1024, swz = sb ^ (((sb >> 9) & 1) << 5); R = (st >> 1) * 16 + swz / 64; C = (st & 1) * 32 + (swz % 64) / 2; }
__host__ __device__ __forceinline__ int perm32(int rho) { const int n = rho >> 4, i = rho & 15; return 8 * (i >> 2) + 4 * n + (i & 3); }

struct Unit { int pm, pn; };
struct Gemm { const bf16_t* A; const bf16_t* Bt; int M, N, K, lda, ldb; };

__device__ __forceinline__ void remap_tile(int wgid, int nM, int nN, int& pm, int& pn) {
    const int nwg = nM * nN;
    { const int q = nwg / NXCD, r = nwg % NXCD, xcd = wgid % NXCD, off = wgid / NXCD; wgid = (xcd < r ? xcd * (q + 1) : r * (q + 1) + (xcd - r) * q) + off; }
    const int nig = WGM * nN, gid = wgid / nig, fm = gid * WGM, gsz = (nM - fm) < WGM ? (nM - fm) : WGM;
    pm = fm + ((wgid % nig) % gsz); pn = (wgid % nig) / gsz;
}
struct StaticOrder {
    int nM, nN, nwg, G, c;
    __device__ void init(int M, int N, int G_, int c_) { nM = M / BM; nN = N / BM; nwg = nM * nN; G = G_; c = c_; }
    __device__ bool next(int i, Unit& u) const {
        const long L = (long)i * G + c; if (L >= nwg) return false;
        remap_tile((int)L, nM, nN, u.pm, u.pn); return true;
    }
    __device__ __forceinline__ int a_coloff(const Unit&) const { return 0; }
};
struct BranchOrder {
    int G, c;
    __device__ bool next(int i, Unit& u) const {
        const int ti = i / 3, br = i - 3 * ti; const long L = (long)ti * G + c; if (L >= 256) return false;
        int pm, pn4; remap_tile((int)L, 64, 4, pm, pn4); u.pm = pm; u.pn = br * 4 + pn4; return true;
    }
    __device__ __forceinline__ int a_coloff(const Unit& u) const { const int br = u.pn >> 2; return br == 0 ? C_QA : (br == 1 ? C_QB : C_QC); }
};

template <class Epi, class Sched>
__device__ __forceinline__ void gemm_phase(LAS unsigned char* lds, const Gemm g, const Sched& S, const Epi& E) {
    int tid_ = threadIdx.x; asm volatile("" : "+v"(tid_));
    const int tid = tid_, wid = __builtin_amdgcn_readfirstlane(tid >> 6), lane = tid & 63, wr = wid >> 2, wc = wid & 3, fr = lane & 15, fq = lane >> 4;
    const int K = g.K, nt = K / BK;
    unsigned voffA[2], voffB[2];
#pragma unroll
    for (int i = 0; i < 2; ++i) { int R, C; stage_rc(tid * 16 + i * 8192, R, C); const int Rb = Epi::PERM ? ((R & ~31) + perm32(R & 31)) : R;
        voffA[i] = (unsigned)(R * g.lda + C) * 2u; voffB[i] = (unsigned)(Rb * g.ldb + C) * 2u; }
    const size_t kstep = (size_t)(BK * 2);
    const size_t hstepA = (size_t)HALF * g.lda * 2, hstepB = (size_t)HALF * g.ldb * 2;
    const size_t tstepA = 2 * hstepA, tstepB = 2 * hstepB;
    const unsigned ldsw = (unsigned)wid * 1024u;
    const int aoff = lds_byte(wr * 64 + fr, fq * 8), boff = lds_byte(wc * 32 + fr, fq * 8);
#define PG8_SA(b, h) (((b) * 2 + (h)) * HTB)
#define PG8_SB(b, h) ((4 + (b) * 2 + (h)) * HTB)
#define PG8_STAGE(bufoff, gbase, voff) do { _Pragma("unroll") for (int _i = 0; _i < 2; ++_i) \
        __builtin_amdgcn_global_load_lds((const unsigned*)((const char*)(gbase) + (voff)[_i]), (LAS unsigned*)(lds + (bufoff) + ldsw + _i * 8192), 16, 0, 0); } while (0)
#define PG8_LDA(dst, b, h) do { _Pragma("unroll") for (int m = 0; m < 4; ++m) _Pragma("unroll") for (int k = 0; k < 2; ++k) dst[m][k] = *(const LAS bf16x8*)(lds + PG8_SA(b, h) + aoff + m * 2048 + k * 1024); } while (0)
#define PG8_LDB(dst, b, h) do { _Pragma("unroll") for (int n = 0; n < 2; ++n) _Pragma("unroll") for (int k = 0; k < 2; ++k) dst[n][k] = *(const LAS bf16x8*)(lds + PG8_SB(b, h) + boff + n * 2048 + k * 1024); } while (0)
#define PG8_MMA(ai, bj, At, Bt) do { __builtin_amdgcn_s_setprio(1); _Pragma("unroll") for (int m = 0; m < 4; ++m) _Pragma("unroll") for (int n = 0; n < 2; ++n) _Pragma("unroll") for (int k = 0; k < 2; ++k) \
        acc[ai][bj][m][n] = __builtin_amdgcn_mfma_f32_16x16x32_bf16(Bt[n][k], At[m][k], acc[ai][bj][m][n], 0, 0, 0); __builtin_amdgcn_s_setprio(0); } while (0)
#define PG8_WAIT_V(n) asm volatile("s_waitcnt vmcnt(" #n ")" ::: "memory")
#define PG8_WAIT_L(n) asm volatile("s_waitcnt lgkmcnt(" #n ")" ::: "memory")
#define PG8_BAR __builtin_amdgcn_s_barrier()
#define PG8_SCHED __builtin_amdgcn_sched_barrier(0)
    Unit cur, nxt; int ui = 0;
    if (!S.next(0, cur)) return;
    f32x4 acc[2][2][4][2];
#pragma unroll
    for (int a = 0; a < 2; ++a)
#pragma unroll
        for (int b = 0; b < 2; ++b)
#pragma unroll
            for (int m = 0; m < 4; ++m)
#pragma unroll
                for (int n = 0; n < 2; ++n) acc[a][b][m][n] = (f32x4){0.f, 0.f, 0.f, 0.f};
    bf16x8 At[4][2], B0[2][2], B1[2][2];
    const char* cA = (const char*)g.A + (size_t)cur.pm * tstepA + (size_t)S.a_coloff(cur) * 2; const char* cB = (const char*)g.Bt + (size_t)cur.pn * tstepB;
    PG8_STAGE(PG8_SB(0, 0), cB, voffB); PG8_STAGE(PG8_SA(0, 0), cA, voffA); PG8_STAGE(PG8_SB(0, 1), cB + hstepB, voffB); PG8_STAGE(PG8_SA(0, 1), cA + hstepA, voffA);
    if (wr == 1) PG8_BAR;
    PG8_WAIT_V(4); PG8_BAR;
    PG8_STAGE(PG8_SB(1, 0), cB + kstep, voffB); PG8_STAGE(PG8_SA(1, 0), cA + kstep, voffA); PG8_STAGE(PG8_SB(1, 1), cB + hstepB + kstep, voffB);
    PG8_WAIT_V(6); PG8_BAR;
    for (;;) {
        const bool has_next = S.next(ui + 1, nxt);
        const char* nA = has_next ? (const char*)g.A + (size_t)nxt.pm * tstepA + (size_t)S.a_coloff(nxt) * 2 : cA; const char* nB = has_next ? (const char*)g.Bt + (size_t)nxt.pn * tstepB : cB;
        for (int t = 0; t < nt; t += 2) {
            const bool last = (t == nt - 2);
            const char* a1 = cA + (size_t)(t + 1) * kstep;
            const char* a2 = last ? nA : cA + (size_t)(t + 2) * kstep; const char* b2 = last ? nB : cB + (size_t)(t + 2) * kstep;
            const char* a3 = a2 + kstep; const char* b3 = b2 + kstep;
            PG8_LDB(B0, 0, 0); PG8_SCHED; PG8_LDA(At, 0, 0); PG8_STAGE(PG8_SA(1, 1), a1 + hstepA, voffA);
            PG8_WAIT_L(8); PG8_BAR; PG8_WAIT_L(0); PG8_MMA(0, 0, At, B0); PG8_BAR; PG8_SCHED;
            PG8_LDB(B1, 0, 1); PG8_STAGE(PG8_SB(0, 0), b2, voffB);
            PG8_BAR; PG8_WAIT_L(0); PG8_MMA(0, 1, At, B1); PG8_BAR;
            PG8_LDA(At, 0, 1); PG8_STAGE(PG8_SA(0, 0), a2, voffA);
            PG8_BAR; PG8_WAIT_L(0); PG8_MMA(1, 0, At, B0); PG8_BAR; PG8_SCHED;
            PG8_STAGE(PG8_SB(0, 1), b2 + hstepB, voffB);
            PG8_WAIT_V(6); PG8_BAR; PG8_MMA(1, 1, At, B1); PG8_BAR;
            PG8_LDB(B0, 1, 0); PG8_SCHED; PG8_LDA(At, 1, 0); PG8_STAGE(PG8_SA(0, 1), a2 + hstepA, voffA);
            PG8_WAIT_L(8); PG8_BAR; PG8_WAIT_L(0); PG8_MMA(0, 0, At, B0); PG8_BAR; PG8_SCHED;
            PG8_LDB(B1, 1, 1); PG8_STAGE(PG8_SB(1, 0), b3, voffB);
            PG8_BAR; PG8_WAIT_L(0); PG8_MMA(0, 1, At, B1); PG8_BAR;
            PG8_LDA(At, 1, 1); PG8_STAGE(PG8_SA(1, 0), a3, voffA);
            PG8_BAR; PG8_WAIT_L(0); PG8_MMA(1, 0, At, B0); PG8_BAR; PG8_SCHED;
            PG8_STAGE(PG8_SB(1, 1), b3 + hstepB, voffB);
            PG8_WAIT_V(6); PG8_BAR; PG8_MMA(1, 1, At, B1); PG8_BAR;
        }
        E(acc, cur, wr, wc, fr, fq);
        if (!has_next) break;
#pragma unroll
        for (int a = 0; a < 2; ++a)
#pragma unroll
            for (int b = 0; b < 2; ++b)
#pragma unroll
                for (int m = 0; m < 4; ++m)
#pragma unroll
                    for (int n = 0; n < 2; ++n) acc[a][b][m][n] = (f32x4){0.f, 0.f, 0.f, 0.f};
        cur = nxt; cA = nA; cB = nB; ++ui;
    }
    PG8_WAIT_V(0);
    if (wr == 0) PG8_BAR;
    PG8_BAR;
#undef PG8_SA
#undef PG8_SB
#undef PG8_STAGE
#undef PG8_LDA
#undef PG8_LDB
#undef PG8_MMA
#undef PG8_WAIT_V
#undef PG8_WAIT_L
#undef PG8_BAR
#undef PG8_SCHED
}

struct EpiSwiGLU {
    static constexpr bool PERM = true;
    bf16_t* H;
    __device__ __forceinline__ void operator()(const f32x4 (&acc)[2][2][4][2], const Unit& u, int wr, int wc, int fr, int fq) const {
        const int row0 = u.pm * BM + wr * 64 + fr, col0 = u.pn * 128 + wc * 32 + 8 * fq;
#pragma unroll
        for (int ai = 0; ai < 2; ++ai)
#pragma unroll
            for (int m = 0; m < 4; ++m) {
                bf16_t* rowp = H + (size_t)(row0 + ai * HALF + m * 16) * DFF + col0;
                const f32x4 g0 = acc[ai][0][m][0], g1 = acc[ai][0][m][1], u0 = acc[ai][1][m][0], u1 = acc[ai][1][m][1];
                float v[8];
#pragma unroll
                for (int j = 0; j < 4; ++j) { v[j] = fast_silu(g0[j]) * u0[j]; v[4 + j] = fast_silu(g1[j]) * u1[j]; }
                u32x4 w; w.x = cvt_pk_bf16(v[0], v[1]); w.y = cvt_pk_bf16(v[2], v[3]); w.z = cvt_pk_bf16(v[4], v[5]); w.w = cvt_pk_bf16(v[6], v[7]);
                *(u32x4*)rowp = w;
            }
    }
};
struct EpiResid {
    static constexpr bool PERM = false;
    const float* res; float* Y; float alpha, s;
    __device__ __forceinline__ void operator()(const f32x4 (&acc)[2][2][4][2], const Unit& u, int wr, int wc, int fr, int fq) const {
        const int row0 = u.pm * BM + wr * 64 + fr, col0 = u.pn * BM + wc * 32 + 4 * fq;
#pragma unroll
        for (int ai = 0; ai < 2; ++ai)
#pragma unroll
            for (int m = 0; m < 4; ++m) { const size_t off = (size_t)(row0 + ai * HALF + m * 16) * DM + col0;
#pragma unroll
                for (int bj = 0; bj < 2; ++bj)
#pragma unroll
                    for (int n = 0; n < 2; ++n) { const f32x4 r = *(const f32x4*)(res + off + bj * HALF + n * 16); *(f32x4*)(Y + off + bj * HALF + n * 16) = r * alpha + acc[ai][bj][m][n] * s; }
                asm volatile("" ::: "memory"); }
    }
};
template <int ACT  , int SHIFT_AT  > struct EpiBiasBf16 {
    static constexpr bool PERM = true;
    bf16_t* O; int ldc; const float* bias;
    __device__ __forceinline__ void operator()(const f32x4 (&acc)[2][2][4][2], const Unit& u, int wr, int wc, int fr, int fq) const {
        const int row0 = u.pm * BM + wr * 64 + fr, col0 = u.pn * BM + wc * 32 + 8 * fq;
        f32x4 bv[2][2];
#pragma unroll
        for (int bj = 0; bj < 2; ++bj) { const int c = col0 + bj * HALF; const int bc = c + (c >= SHIFT_AT ? 8 : 0);
            bv[bj][0] = *(const f32x4*)(bias + bc); bv[bj][1] = *(const f32x4*)(bias + bc + 4); }
#pragma unroll
        for (int ai = 0; ai < 2; ++ai)
#pragma unroll
            for (int m = 0; m < 4; ++m) { bf16_t* rowp = O + (size_t)(row0 + ai * HALF + m * 16) * ldc + col0;
#pragma unroll
                for (int bj = 0; bj < 2; ++bj) { f32x4 v0 = acc[ai][bj][m][0] + bv[bj][0], v1 = acc[ai][bj][m][1] + bv[bj][1];
                    if (ACT == 1) {
#pragma unroll
                        for (int j = 0; j < 4; ++j) { v0[j] = fast_sigmoid(v0[j]); v1[j] = fast_sigmoid(v1[j]); } }
                    u32x4 w; w.x = cvt_pk_bf16(v0[0], v0[1]); w.y = cvt_pk_bf16(v0[2], v0[3]); w.z = cvt_pk_bf16(v1[0], v1[1]); w.w = cvt_pk_bf16(v1[2], v1[3]);
                    *(u32x4*)(rowp + bj * HALF) = w; } }
    }
};
struct EpiBranch {
    static constexpr bool PERM = true;
    const bf16_t* gates; bf16_t* MG;
    __device__ __forceinline__ void operator()(const f32x4 (&acc)[2][2][4][2], const Unit& u, int wr, int wc, int fr, int fq) const {
        const int br = u.pn >> 2, pn4 = u.pn & 3;
        const int row0 = u.pm * BM + wr * 64 + fr, col0 = pn4 * BM + wc * 32 + 8 * fq;
#pragma unroll
        for (int ai = 0; ai < 2; ++ai)
#pragma unroll
            for (int m = 0; m < 4; ++m) { const size_t r = (size_t)(row0 + ai * HALF + m * 16);
#pragma unroll
                for (int bj = 0; bj < 2; ++bj) { const int c = col0 + bj * HALF;
                    const u32x4 gw = *(const u32x4*)(gates + r * 3072 + br * 1024 + c);
                    const f32x4 a0 = acc[ai][bj][m][0], a1 = acc[ai][bj][m][1];
                    float v[8];
                    v[0] = bf_lo(gw.x) * a0[0]; v[1] = bf_hi(gw.x) * a0[1]; v[2] = bf_lo(gw.y) * a0[2]; v[3] = bf_hi(gw.y) * a0[3];
                    v[4] = bf_lo(gw.z) * a1[0]; v[5] = bf_hi(gw.z) * a1[1]; v[6] = bf_lo(gw.w) * a1[2]; v[7] = bf_hi(gw.w) * a1[3];
                    if (br > 0) { const u32x4 pw = *(const u32x4*)(MG + r * DM + c);
                        v[0] += bf_lo(pw.x); v[1] += bf_hi(pw.x); v[2] += bf_lo(pw.y); v[3] += bf_hi(pw.y); v[4] += bf_lo(pw.z); v[5] += bf_hi(pw.z); v[6] += bf_lo(pw.w); v[7] += bf_hi(pw.w); }
                    u32x4 w; w.x = cvt_pk_bf16(v[0], v[1]); w.y = cvt_pk_bf16(v[2], v[3]); w.z = cvt_pk_bf16(v[4], v[5]); w.w = cvt_pk_bf16(v[6], v[7]);
                    *(u32x4*)(MG + r * DM + c) = w; }
                asm volatile("" ::: "memory"); }
    }
};
}

struct Params { const float* in[25]; float* out; unsigned char* ws; };
enum { I_X = 0, I_LN1G, I_LN1B, I_FF1IN, I_FF1OUT, I_WIN, I_BIN, I_CONVW, I_ALOG, I_DTB, I_GNG, I_RELB, I_SINKS, I_WGATE, I_BGATE, I_WBRA, I_WBRB, I_WBRC, I_WOUT, I_LN2G, I_LN2B, I_FF2IN, I_FF2OUT, I_LN3G, I_LN3B };

__device__ __forceinline__ float wave_sum(float v) {
#pragma unroll
    for (int o = 32; o >= 1; o >>= 1) v += __shfl_xor(v, o);
    return v;
}

__device__ __forceinline__ int colmap(int kind, int n) {
    if (kind == 1) { const int t = n >> 8, w = n & 255; return (w < 128) ? (t * 128 + w) : (DFF + t * 128 + (w - 128)); }
    if (kind == 2) return n < 1536 ? n : n + 8;
    return n;
}
__device__ __forceinline__ void cv_tiles(float* tile  , bf16_t* dst, int N, int K, const float* src, int ld, int kind, int bid, int nblk) {
    int tid_ = threadIdx.x; asm volatile("" : "+v"(tid_)); const int tid = tid_;
    const int tk = K / 64, ntile = (N / 64) * tk;
    for (int t = bid; t < ntile; t += nblk) {
        const int n0 = (t / tk) * 64, k0 = (t % tk) * 64;
#pragma unroll
        for (int i = 0; i < 8; ++i) { const int e = tid + i * 512, kk = e >> 6, nn = e & 63;
            tile[kk * 65 + nn] = src[(size_t)(k0 + kk) * ld + colmap(kind, n0 + nn)]; }
        __syncthreads();
        { const int nn = tid >> 3, k8 = (tid & 7) * 8; float v[8];
#pragma unroll
          for (int i = 0; i < 8; ++i) v[i] = tile[(k8 + i) * 65 + nn];
          u32x4 w; w.x = cvt_pk_bf16(v[0], v[1]); w.y = cvt_pk_bf16(v[2], v[3]); w.z = cvt_pk_bf16(v[4], v[5]); w.w = cvt_pk_bf16(v[6], v[7]);
          *(u32x4*)(dst + (size_t)(n0 + nn) * K + k0 + k8) = w; }
        __syncthreads();
    }
}

__device__ __forceinline__ void ln_phase(float* ldsf, const float* Y, const float* gam, const float* bet, float* XF, bf16_t* XB,
                         bool do_bg, const float* w_in, const float* b_in, const float* a_log, const float* dt_bias, float* BETA, float* GLOG) {
    int tid_ = threadIdx.x; asm volatile("" : "+v"(tid_)); const int tid = tid_, wv = tid >> 6, l = tid & 63;
    if (do_bg) { for (int e = tid; e < 8192; e += 512) ldsf[e] = w_in[(size_t)(e >> 3) * WIN_LD + 1536 + (e & 7)]; }
    __syncthreads();
    f32x4 gv[4], bv[4];
#pragma unroll
    for (int i = 0; i < 4; ++i) { gv[i] = *(const f32x4*)(gam + i * 256 + l * 4); bv[i] = *(const f32x4*)(bet + i * 256 + l * 4); }
    for (int row = blockIdx.x * 8 + wv; row < M_TOK; row += gridDim.x * 8) {
        f32x4 v[4];
#pragma unroll
        for (int i = 0; i < 4; ++i) v[i] = *(const f32x4*)(Y + (size_t)row * DM + i * 256 + l * 4);
        float s = 0.f;
#pragma unroll
        for (int i = 0; i < 4; ++i) s += (v[i][0] + v[i][1]) + (v[i][2] + v[i][3]);
        const float mean = wave_sum(s) * (1.0f / 1024.0f);
        float q = 0.f;
#pragma unroll
        for (int i = 0; i < 4; ++i) { v[i] = v[i] - mean; q += (v[i][0] * v[i][0] + v[i][1] * v[i][1]) + (v[i][2] * v[i][2] + v[i][3] * v[i][3]); }
        const float rstd = rsqrtf(wave_sum(q) * (1.0f / 1024.0f) + 1e-5f);
#pragma unroll
        for (int i = 0; i < 4; ++i) {
            v[i] = v[i] * rstd * gv[i] + bv[i];
            *(f32x4*)(XF + (size_t)row * DM + i * 256 + l * 4) = v[i];
            u32x2 w; w.x = cvt_pk_bf16(v[i][0], v[i][1]); w.y = cvt_pk_bf16(v[i][2], v[i][3]);
            *(u32x2*)(XB + (size_t)row * DM + i * 256 + l * 4) = w;
        }
        if (do_bg) {
            float d[8];
#pragma unroll
            for (int j = 0; j < 8; ++j) d[j] = 0.f;
#pragma unroll
            for (int i = 0; i < 4; ++i)
#pragma unroll
                for (int jj = 0; jj < 4; ++jj) { const int k = i * 256 + l * 4 + jj; const f32x4 w0 = *(const f32x4*)(ldsf + k * 8), w1 = *(const f32x4*)(ldsf + k * 8 + 4); const float x = v[i][jj];
                    d[0] += x * w0[0]; d[1] += x * w0[1]; d[2] += x * w0[2]; d[3] += x * w0[3]; d[4] += x * w1[0]; d[5] += x * w1[1]; d[6] += x * w1[2]; d[7] += x * w1[3]; }
#pragma unroll
            for (int j = 0; j < 8; ++j) d[j] = wave_sum(d[j]);
            if (l == 0) {
                f32x4 bo, go;
#pragma unroll
                for (int h = 0; h < 4; ++h) {
                    bo[h] = 1.0f / (1.0f + expf(-(d[h] + b_in[1536 + h])));
                    const float xa = d[4 + h] + b_in[1540 + h] + dt_bias[h];
                    const float sp = xa > 20.f ? xa : log1pf(expf(xa));
                    go[h] = -expf(a_log[h]) * sp;
                }
                *(f32x4*)(BETA + (size_t)row * 4) = bo; *(f32x4*)(GLOG + (size_t)row * 4) = go;
            }
        }
    }
}

__device__ __forceinline__ void prep_phase(const bf16_t* PROJ, const float* conv_w, bf16_t* QN, bf16_t* KN, bf16_t* VC) {
    int tid_ = threadIdx.x; asm volatile("" : "+v"(tid_)); const int tid = tid_, wv = tid >> 6, l = tid & 63;
    for (int r = blockIdx.x * 8 + wv; r < M_TOK * 12; r += gridDim.x * 8) {
        const int tok = r / 12, wh = r - tok * 12, which = wh >> 2, h = wh & 3;
        const int ch = which * 512 + h * 128 + 2 * l;
        const int tpos = tok & (SEQ - 1);
        float a0 = 0.f, a1 = 0.f;
#pragma unroll
        for (int i = 0; i < 4; ++i) {
            if (tpos - 3 + i >= 0) {
                const unsigned pv = *(const unsigned*)(PROJ + (size_t)(tok - 3 + i) * PROJ_LD + ch);
                const f32x2 cw = *(const f32x2*)(conv_w + i * 1536 + ch);
                a0 += cw[0] * bf_lo(pv); a1 += cw[1] * bf_hi(pv);
            }
        }
        a0 = a0 / (1.0f + expf(-a0)); a1 = a1 / (1.0f + expf(-a1));
        if (which < 2) {
            const float ss = wave_sum(a0 * a0 + a1 * a1);
            float rs = rsqrtf(ss + 1e-6f);
            if (which == 0) rs *= 0.08838834764831845f;
            a0 *= rs; a1 *= rs;
        }
        bf16_t* dst = which == 0 ? QN : (which == 1 ? KN : VC);
        *(unsigned*)(dst + (size_t)tok * 512 + h * 128 + 2 * l) = cvt_pk_bf16(a0, a1);
    }
}

__device__ __forceinline__ void delta_recurrent(float* ldsf, int bh, bf16_t* PROJ, const bf16_t* QN, const bf16_t* KN, const bf16_t* VC, const float* BETA, const float* GLOG, const float* norm_g) {
    int tid_ = threadIdx.x; asm volatile("" : "+v"(tid_)); const int tid = tid_, wv = tid >> 6, l = tid & 63, c = l & 15, gq = l >> 4;
    const int b = bh >> 2, h = bh & 3;
    float* qs = ldsf; float* ks = ldsf + 8192; float* vs = ldsf + 16384; float* Os = ldsf + 24576; float* al = ldsf + 32768; float* be = al + 64;
    float s[32];
#pragma unroll
    for (int i = 0; i < 32; ++i) s[i] = 0.f;
    for (int n = 0; n < NCHUNK; ++n) {
        const size_t row0 = (size_t)b * SEQ + n * 64;
        __syncthreads();
#pragma unroll
        for (int it = 0; it < 2; ++it) { const int e = tid + it * 512, t = e >> 4, p8 = (e & 15) * 8;
            const size_t g = (row0 + t) * 512 + h * 128 + p8;
            const u32x4 qw = *(const u32x4*)(QN + g), kw = *(const u32x4*)(KN + g), vw = *(const u32x4*)(VC + g);
            float* qd = qs + t * 128 + p8; float* kd = ks + t * 128 + p8; float* vd = vs + t * 128 + p8;
            *(f32x4*)qd = (f32x4){bf_lo(qw.x), bf_hi(qw.x), bf_lo(qw.y), bf_hi(qw.y)}; *(f32x4*)(qd + 4) = (f32x4){bf_lo(qw.z), bf_hi(qw.z), bf_lo(qw.w), bf_hi(qw.w)};
            *(f32x4*)kd = (f32x4){bf_lo(kw.x), bf_hi(kw.x), bf_lo(kw.y), bf_hi(kw.y)}; *(f32x4*)(kd + 4) = (f32x4){bf_lo(kw.z), bf_hi(kw.z), bf_lo(kw.w), bf_hi(kw.w)};
            *(f32x4*)vd = (f32x4){bf_lo(vw.x), bf_hi(vw.x), bf_lo(vw.y), bf_hi(vw.y)}; *(f32x4*)(vd + 4) = (f32x4){bf_lo(vw.z), bf_hi(vw.z), bf_lo(vw.w), bf_hi(vw.w)};
        }
        if (tid < 64) { al[tid] = expf(GLOG[(row0 + tid) * 4 + h]); be[tid] = BETA[(row0 + tid) * 4 + h]; }
        __syncthreads();
        for (int t = 0; t < 64; ++t) {
            const float a = al[t], bt = be[t];
            float kk[32], qq[32];
#pragma unroll
            for (int i = 0; i < 8; ++i) { const f32x4 kv = *(const f32x4*)(ks + t * 128 + gq * 32 + i * 4); kk[4 * i] = kv[0]; kk[4 * i + 1] = kv[1]; kk[4 * i + 2] = kv[2]; kk[4 * i + 3] = kv[3];
                                          const f32x4 qv = *(const f32x4*)(qs + t * 128 + gq * 32 + i * 4); qq[4 * i] = qv[0]; qq[4 * i + 1] = qv[1]; qq[4 * i + 2] = qv[2]; qq[4 * i + 3] = qv[3]; }
            float k0 = 0.f, k1 = 0.f, k2 = 0.f, k3 = 0.f;
#pragma unroll
            for (int i = 0; i < 32; i += 4) { k0 += kk[i] * s[i]; k1 += kk[i + 1] * s[i + 1]; k2 += kk[i + 2] * s[i + 2]; k3 += kk[i + 3] * s[i + 3]; }
            float ksum = (k0 + k1) + (k2 + k3);
            ksum += __shfl_xor(ksum, 16); ksum += __shfl_xor(ksum, 32);
            const float vn = bt * (vs[t * 128 + wv * 16 + c] - a * ksum);
#pragma unroll
            for (int i = 0; i < 32; ++i) s[i] = a * s[i] + kk[i] * vn;
            float o0 = 0.f, o1 = 0.f, o2 = 0.f, o3 = 0.f;
#pragma unroll
            for (int i = 0; i < 32; i += 4) { o0 += qq[i] * s[i]; o1 += qq[i + 1] * s[i + 1]; o2 += qq[i + 2] * s[i + 2]; o3 += qq[i + 3] * s[i + 3]; }
            float os = (o0 + o1) + (o2 + o3);
            os += __shfl_xor(os, 16); os += __shfl_xor(os, 32);
            if (gq == 0) Os[t * 128 + wv * 16 + c] = os;
        }
        __syncthreads();
        {
            const int t = tid >> 3, j8 = tid & 7;
            float o[16]; float ss = 0.f;
#pragma unroll
            for (int i = 0; i < 4; ++i) { const f32x4 ov = *(const f32x4*)(Os + t * 128 + j8 * 16 + i * 4); o[4 * i] = ov[0]; o[4 * i + 1] = ov[1]; o[4 * i + 2] = ov[2]; o[4 * i + 3] = ov[3]; }
#pragma unroll
            for (int i = 0; i < 16; ++i) ss += o[i] * o[i];
            ss += __shfl_xor(ss, 1); ss += __shfl_xor(ss, 2); ss += __shfl_xor(ss, 4);
            const float rs = rsqrtf(ss * (1.0f / 128.0f) + 1e-6f);
            bf16_t* prow = PROJ + (row0 + t) * PROJ_LD + h * 128 + j8 * 16;
            const u32x4 z0 = *(const u32x4*)(prow + C_ZA), z1 = *(const u32x4*)(prow + C_ZA + 8);
            const unsigned zw[8] = {z0.x, z0.y, z0.z, z0.w, z1.x, z1.y, z1.z, z1.w};
            unsigned ow[8];
#pragma unroll
            for (int i = 0; i < 8; ++i) {
                const float za = bf_lo(zw[i]), zb = bf_hi(zw[i]);
                const float ra = o[2 * i] * rs * norm_g[j8 * 16 + 2 * i] * (za / (1.0f + expf(-za)));
                const float rb = o[2 * i + 1] * rs * norm_g[j8 * 16 + 2 * i + 1] * (zb / (1.0f + expf(-zb)));
                ow[i] = cvt_pk_bf16(ra, rb);
            }
            *(u32x4*)(prow + C_QA) = (u32x4){ow[0], ow[1], ow[2], ow[3]}; *(u32x4*)(prow + C_QA + 8) = (u32x4){ow[4], ow[5], ow[6], ow[7]};
        }
    }
}


#define DPP_ADD(x, CTRL) ((x) + __int_as_float(__builtin_amdgcn_update_dpp(0, __float_as_int(x), CTRL, 0xF, 0xF, true)))
#define ROW16_SUM(x) do { x = DPP_ADD(x, 0xB1); x = DPP_ADD(x, 0x4E); x = DPP_ADD(x, 0x124); x = DPP_ADD(x, 0x128); } while (0)
__device__ __forceinline__ void delta_recurrent4(float* ldsf, int u, const bf16_t* PROJ, const float* conv_w, const float* BETA, const float* GLOG, float* ORAW) {
    int tid_ = threadIdx.x; asm volatile("" : "+v"(tid_)); const int tid = tid_, wv = tid >> 6, l = tid & 63, c = l >> 4, gq = l & 15;
    const int bh = u >> 2, qd = u & 3, b = bh >> 2, h = bh & 3;
    float* qs = ldsf; float* ks = ldsf + 8192; float* vs = ldsf + 16384; float* al = ldsf + 16384 + 2048; float* be = al + 64;
    float s[8];
#pragma unroll
    for (int i = 0; i < 8; ++i) s[i] = 0.f;
    const int dvc = qd * 32 + wv * 4 + c;
    for (int n = 0; n < NCHUNK; ++n) {
        const size_t row0 = (size_t)b * SEQ + n * 64;
        __syncthreads();
#pragma unroll
        for (int it = 0; it < 2; ++it) { const int e = tid + it * 512, t = e >> 4, p8 = (e & 15) * 8;
#pragma unroll
            for (int which = 0; which < 2; ++which) {
                const int ch = which * 512 + h * 128 + p8;
                float acc[8];
#pragma unroll
                for (int k = 0; k < 8; ++k) acc[k] = 0.f;
#pragma unroll
                for (int i = 0; i < 4; ++i) {
                    if (n * 64 + t - 3 + i >= 0) {
                        const u32x4 xw = *(const u32x4*)(PROJ + (row0 + t - 3 + i) * PROJ_LD + ch);
                        const f32x4 c0 = *(const f32x4*)(conv_w + i * 1536 + ch), c1 = *(const f32x4*)(conv_w + i * 1536 + ch + 4);
                        acc[0] += c0[0] * bf_lo(xw.x); acc[1] += c0[1] * bf_hi(xw.x); acc[2] += c0[2] * bf_lo(xw.y); acc[3] += c0[3] * bf_hi(xw.y);
                        acc[4] += c1[0] * bf_lo(xw.z); acc[5] += c1[1] * bf_hi(xw.z); acc[6] += c1[2] * bf_lo(xw.w); acc[7] += c1[3] * bf_hi(xw.w);
                    }
                }
                float ss = 0.f;
#pragma unroll
                for (int k = 0; k < 8; ++k) { acc[k] = acc[k] / (1.0f + __expf(-acc[k])); ss += acc[k] * acc[k]; }
                ROW16_SUM(ss);
                float rs = rsqrtf(ss + 1e-6f); if (which == 0) rs *= 0.08838834764831845f;
                float* dd = (which == 0 ? qs : ks) + t * 128 + p8;
                *(f32x4*)dd = (f32x4){acc[0] * rs, acc[1] * rs, acc[2] * rs, acc[3] * rs}; *(f32x4*)(dd + 4) = (f32x4){acc[4] * rs, acc[5] * rs, acc[6] * rs, acc[7] * rs};
            }
        }
        if (tid < 256) { const int t = tid >> 2, p8 = (tid & 3) * 8;
            const int ch = 1024 + h * 128 + qd * 32 + p8;
            float acc[8];
#pragma unroll
            for (int k = 0; k < 8; ++k) acc[k] = 0.f;
#pragma unroll
            for (int i = 0; i < 4; ++i) {
                if (n * 64 + t - 3 + i >= 0) {
                    const u32x4 xw = *(const u32x4*)(PROJ + (row0 + t - 3 + i) * PROJ_LD + ch);
                    const f32x4 c0 = *(const f32x4*)(conv_w + i * 1536 + ch), c1 = *(const f32x4*)(conv_w + i * 1536 + ch + 4);
                    acc[0] += c0[0] * bf_lo(xw.x); acc[1] += c0[1] * bf_hi(xw.x); acc[2] += c0[2] * bf_lo(xw.y); acc[3] += c0[3] * bf_hi(xw.y);
                    acc[4] += c1[0] * bf_lo(xw.z); acc[5] += c1[1] * bf_hi(xw.z); acc[6] += c1[2] * bf_lo(xw.w); acc[7] += c1[3] * bf_hi(xw.w);
                }
            }
            float* vd = vs + t * 32 + p8;
#pragma unroll
            for (int k = 0; k < 8; ++k) acc[k] = acc[k] / (1.0f + __expf(-acc[k]));
            *(f32x4*)vd = (f32x4){acc[0], acc[1], acc[2], acc[3]}; *(f32x4*)(vd + 4) = (f32x4){acc[4], acc[5], acc[6], acc[7]};
        }
        if (tid < 64) { al[tid] = expf(GLOG[(row0 + tid) * 4 + h]); be[tid] = BETA[(row0 + tid) * 4 + h]; }
        __syncthreads();
        for (int t = 0; t < 64; ++t) {
            const float a = al[t], bt = be[t];
            const f32x4 k0 = *(const f32x4*)(ks + t * 128 + gq * 8), k1 = *(const f32x4*)(ks + t * 128 + gq * 8 + 4);
            const f32x4 q0 = *(const f32x4*)(qs + t * 128 + gq * 8), q1 = *(const f32x4*)(qs + t * 128 + gq * 8 + 4);
            float ksum = ((k0[0] * s[0] + k0[1] * s[1]) + (k0[2] * s[2] + k0[3] * s[3])) + ((k1[0] * s[4] + k1[1] * s[5]) + (k1[2] * s[6] + k1[3] * s[7]));
            ROW16_SUM(ksum);
            const float vn = bt * (vs[t * 32 + wv * 4 + c] - a * ksum);
            s[0] = a * s[0] + k0[0] * vn; s[1] = a * s[1] + k0[1] * vn; s[2] = a * s[2] + k0[2] * vn; s[3] = a * s[3] + k0[3] * vn;
            s[4] = a * s[4] + k1[0] * vn; s[5] = a * s[5] + k1[1] * vn; s[6] = a * s[6] + k1[2] * vn; s[7] = a * s[7] + k1[3] * vn;
            float os = ((q0[0] * s[0] + q0[1] * s[1]) + (q0[2] * s[2] + q0[3] * s[3])) + ((q1[0] * s[4] + q1[1] * s[5]) + (q1[2] * s[6] + q1[3] * s[7]));
            ROW16_SUM(os);
            if (gq == 0) ORAW[(row0 + t) * 512 + h * 128 + dvc] = os;
        }
    }
}
__device__ __forceinline__ void delta_norm_phase(const float* ORAW, bf16_t* PROJ, const float* norm_g) {
    int tid_ = threadIdx.x; asm volatile("" : "+v"(tid_)); const int tid = tid_, wv = tid >> 6, l = tid & 63;
    const f32x2 ng = *(const f32x2*)(norm_g + 2 * l);
    for (int r = blockIdx.x * 8 + wv; r < M_TOK * 4; r += gridDim.x * 8) {
        const int tok = r >> 2, h = r & 3;
        const f32x2 o = *(const f32x2*)(ORAW + (size_t)tok * 512 + h * 128 + 2 * l);
        const float ss = wave_sum(o[0] * o[0] + o[1] * o[1]);
        const float rs = rsqrtf(ss * (1.0f / 128.0f) + 1e-6f);
        bf16_t* prow = PROJ + (size_t)tok * PROJ_LD + h * 128 + 2 * l;
        const unsigned zw = *(const unsigned*)(prow + C_ZA);
        const float za = bf_lo(zw), zb = bf_hi(zw);
        *(unsigned*)(prow + C_QA) = cvt_pk_bf16(o[0] * rs * ng[0] * (za / (1.0f + expf(-za))), o[1] * rs * ng[1] * (zb / (1.0f + expf(-zb))));
    }
}
template <int D, bool MODE_C>
__device__ __forceinline__ void attn_half(unsigned char* hl, bf16_t* PROJ, int b, int n, int qcol, int kcol, int vcol, const float* rb, float slope, float sink, int htid) {
    constexpr int NPREV = MODE_C ? 2 : 8;
    constexpr int KP = D + 8;
    bf16_t* Ks = (bf16_t*)hl; bf16_t* Vt = (bf16_t*)(hl + 64 * KP * 2); float* rbs = (float*)(hl + 64 * KP * 2 + D * 72 * 2);
    const int w4 = htid >> 6, l = htid & 63, lr = l & 15, lg = l >> 4, q0 = w4 * 16;
    const float scale = MODE_C ? 0.125f : 0.08838834764831845f;
    const size_t qrow = (size_t)b * SEQ + n * 64 + q0 + lr;
    bf16x8 qf[D / 32];
#pragma unroll
    for (int ks = 0; ks < D / 32; ++ks) qf[ks] = *(const bf16x8*)(PROJ + qrow * PROJ_LD + qcol + ks * 32 + lg * 8);
    if (!MODE_C) { if (htid < 192) rbs[htid] = rb[htid]; }
    f32x4 o[D / 16];
#pragma unroll
    for (int i = 0; i < D / 16; ++i) o[i] = (f32x4){0.f, 0.f, 0.f, 0.f};
    float mrun = -1e30f, lsum = 0.f;
    const int kc0 = n - NPREV < 0 ? 0 : n - NPREV;
    for (int kc = kc0; kc <= n; ++kc) {
        __syncthreads();
        const size_t krow0 = (size_t)b * SEQ + kc * 64;
#pragma unroll
        for (int it = 0; it < (64 * (D / 8)) / 256; ++it) {
            const int e = htid + it * 256, r = e / (D / 8), p8 = e % (D / 8);
            *(u32x4*)(Ks + r * KP + p8 * 8) = *(const u32x4*)(PROJ + (krow0 + r) * PROJ_LD + kcol + p8 * 8);
        }
#pragma unroll
        for (int it = 0; it < (64 * (D / 8)) / 256; ++it) {
            const int e = htid + it * 256, r = e & 63, p8 = e >> 6;
            const u32x4 vw = *(const u32x4*)(PROJ + (krow0 + r) * PROJ_LD + vcol + p8 * 8);
            bf16_t* vd = Vt + (p8 * 8) * 72 + r;
            vd[0] = (bf16_t)(vw.x & 0xffff); vd[72] = (bf16_t)(vw.x >> 16); vd[144] = (bf16_t)(vw.y & 0xffff); vd[216] = (bf16_t)(vw.y >> 16);
            vd[288] = (bf16_t)(vw.z & 0xffff); vd[360] = (bf16_t)(vw.z >> 16); vd[432] = (bf16_t)(vw.w & 0xffff); vd[504] = (bf16_t)(vw.w >> 16);
        }
        __syncthreads();
        f32x4 st[4];
#pragma unroll
        for (int kt = 0; kt < 4; ++kt) {
            st[kt] = (f32x4){0.f, 0.f, 0.f, 0.f};
#pragma unroll
            for (int ks = 0; ks < D / 32; ++ks) {
                const bf16x8 a = *(const bf16x8*)(Ks + (kt * 16 + lr) * KP + ks * 32 + lg * 8);
                st[kt] = __builtin_amdgcn_mfma_f32_16x16x32_bf16(a, qf[ks], st[kt], 0, 0, 0);
            }
        }
        const int dbase = (n - kc) * 64 + q0 + lr;
        float mc = -1e30f;
#pragma unroll
        for (int kt = 0; kt < 4; ++kt)
#pragma unroll
            for (int j = 0; j < 4; ++j) {
                const int dist = dbase - (kt * 16 + lg * 4 + j);
                float sv;
                if (MODE_C) sv = st[kt][j] * scale - slope * fabsf((float)dist);
                else { const int idx = (dist > 128 ? 128 : dist) + 63; sv = st[kt][j] * scale + rbs[idx]; }
                st[kt][j] = sv; mc = fmaxf(mc, sv);
            }
        mc = fmaxf(mc, __shfl_xor(mc, 16)); mc = fmaxf(mc, __shfl_xor(mc, 32));
        const float mnew = fmaxf(mrun, mc), corr = __expf(mrun - mnew);
        mrun = mnew;
        float ps = 0.f;
#pragma unroll
        for (int kt = 0; kt < 4; ++kt)
#pragma unroll
            for (int j = 0; j < 4; ++j) { const float p = __expf(st[kt][j] - mnew); st[kt][j] = p; ps += p; }
        lsum = lsum * corr + ps;
#pragma unroll
        for (int i = 0; i < D / 16; ++i) o[i] = o[i] * corr;
        bf16x8 pb[2];
#pragma unroll
        for (int k2 = 0; k2 < 2; ++k2) {
            u32x4 w; w.x = cvt_pk_bf16(st[2 * k2][0], st[2 * k2][1]); w.y = cvt_pk_bf16(st[2 * k2][2], st[2 * k2][3]);
            w.z = cvt_pk_bf16(st[2 * k2 + 1][0], st[2 * k2 + 1][1]); w.w = cvt_pk_bf16(st[2 * k2 + 1][2], st[2 * k2 + 1][3]);
            pb[k2] = __builtin_bit_cast(bf16x8, w);
        }
#pragma unroll
        for (int dt = 0; dt < D / 16; ++dt)
#pragma unroll
            for (int k2 = 0; k2 < 2; ++k2) {
                const bf16_t* vp = Vt + (dt * 16 + lr) * 72 + lg * 4;
                const u32x2 lo = *(const u32x2*)(vp + (2 * k2) * 16), hi = *(const u32x2*)(vp + (2 * k2 + 1) * 16);
                const u32x4 aw = (u32x4){lo.x, lo.y, hi.x, hi.y};
                o[dt] = __builtin_amdgcn_mfma_f32_16x16x32_bf16(__builtin_bit_cast(bf16x8, aw), pb[k2], o[dt], 0, 0, 0);
            }
    }
    lsum += __shfl_xor(lsum, 16); lsum += __shfl_xor(lsum, 32);
    if (MODE_C) lsum += __expf(sink - mrun);
    const float inv = 1.0f / lsum;
    bf16_t* orow = PROJ + qrow * PROJ_LD + qcol + lg * 4;
#pragma unroll
    for (int dt = 0; dt < D / 16; ++dt) {
        u32x2 w; w.x = cvt_pk_bf16(o[dt][0] * inv, o[dt][1] * inv); w.y = cvt_pk_bf16(o[dt][2] * inv, o[dt][3] * inv);
        *(u32x2*)(orow + dt * 16) = w;
    }
}
constexpr int ATT_HALF_BYTES = 40960;
__device__ __forceinline__ void attn_item(unsigned char* lds, int it, bf16_t* PROJ, const float* rel_bias, const float* sinks) {
    int tid_ = threadIdx.x; asm volatile("" : "+v"(tid_)); const int tid = tid_, half = tid >> 8, htid = tid & 255;
    unsigned char* hl = lds + half * ATT_HALF_BYTES;
    if (it < 512) {
        const int b = it >> 6, n = (it >> 1) & 31, h = (it & 1) * 2 + half;
        attn_half<128, false>(hl, PROJ, b, n, C_QB + h * 128, C_KB + h * 128, C_VB + h * 128, rel_bias + h * 192, 0.f, 0.f, htid);
    } else {
        const int i2 = it - 512, b = i2 >> 7, n = (i2 >> 2) & 31, hq = (i2 & 3) * 2 + half, hkv = hq >> 2;
        const float slope = exp2f(-(float)(hq + 1));
        attn_half<64, true>(hl, PROJ, b, n, C_QC + hq * 64, C_KC + hkv * 64, C_VC + hkv * 64, nullptr, slope, sinks[hq], htid);
    }
}

constexpr int LDS_BYTES = 135168;
constexpr int SCAN_BLOCKS = 128;

__device__ __forceinline__ const Params* get_pp() {
    const unsigned char* ka = (const unsigned char*)__builtin_amdgcn_kernarg_segment_ptr(); asm volatile("" : "+s"(ka)); return (const Params*)ka;
}
#define WSPTR(T, off) ((T*)(ws + (off)))
#define PH_BEGIN const Params* pp = get_pp(); unsigned char* ws = pp->ws; (void)ws; int G = G0, bid = bid0; asm volatile("" : "+s"(G), "+s"(bid));

template <int l>
__device__ __forceinline__ void layer_body(cg::grid_group& grid, const int G0, const int bid0, unsigned char* lds, LAS unsigned char* ldsl, float* ldsf, const float alpha) {
        { PH_BEGIN
          pg8::Gemm g{WSPTR(bf16_t, WS_XB), WSPTR(bf16_t, WS_SLOTA), M_TOK, 8192, DM, DM, DM}; pg8::StaticOrder S; S.init(M_TOK, 8192, G, bid); pg8::EpiSwiGLU E{WSPTR(bf16_t, WS_H)};
          pg8::gemm_phase(ldsl, g, S, E); }
        grid.sync();
        { PH_BEGIN
          pg8::Gemm g{WSPTR(bf16_t, WS_H), WSPTR(bf16_t, WS_SLOTB), M_TOK, DM, DFF, DFF, DFF}; pg8::StaticOrder S; S.init(M_TOK, DM, G, bid);
          pg8::EpiResid E{l == 0 ? pp->in[I_X] : (const float*)pp->out, WSPTR(float, WS_YFFN), alpha, 0.5f};
          pg8::gemm_phase(ldsl, g, S, E); }
        grid.sync();
        { PH_BEGIN
          const float* w_in = pp->in[I_WIN] + (size_t)l * DM * WIN_LD;
          cv_tiles(ldsf, WSPTR(bf16_t, WS_SLOTA), PROJ_LD, DM, w_in, WIN_LD, 2, bid, G);
          cv_tiles(ldsf, WSPTR(bf16_t, WS_SLOTB + SB_WGATE), 3072, DM, pp->in[I_WGATE] + (size_t)l * DM * 3072, 3072, 0, bid, G);
          cv_tiles(ldsf, WSPTR(bf16_t, WS_SLOTB + SB_WBR), 1024, 512, pp->in[I_WBRA] + (size_t)l * 512 * DM, DM, 0, bid, G);
          cv_tiles(ldsf, WSPTR(bf16_t, WS_SLOTB + SB_WBR) + 1024 * 512, 1024, 512, pp->in[I_WBRB] + (size_t)l * 512 * DM, DM, 0, bid, G);
          cv_tiles(ldsf, WSPTR(bf16_t, WS_SLOTB + SB_WBR) + 2048 * 512, 1024, 512, pp->in[I_WBRC] + (size_t)l * 512 * DM, DM, 0, bid, G);
          cv_tiles(ldsf, WSPTR(bf16_t, WS_SLOTB + SB_WOUT), DM, DM, pp->in[I_WOUT] + (size_t)l * DM * DM, DM, 0, bid, G);
          ln_phase(ldsf, WSPTR(float, WS_YFFN), pp->in[I_LN1G] + l * DM, pp->in[I_LN1B] + l * DM, pp->out, WSPTR(bf16_t, WS_XB), true, w_in, pp->in[I_BIN] + (size_t)l * WIN_LD,
                   pp->in[I_ALOG] + l * 4, pp->in[I_DTB] + l * 4, WSPTR(float, WS_BETA), WSPTR(float, WS_GLOG)); }
        grid.sync();
        { PH_BEGIN
          pg8::Gemm g{WSPTR(bf16_t, WS_XB), WSPTR(bf16_t, WS_SLOTA), M_TOK, PROJ_LD, DM, DM, DM}; pg8::StaticOrder S; S.init(M_TOK, PROJ_LD, G, bid);
          pg8::EpiBiasBf16<0, 1536> E{WSPTR(bf16_t, WS_PROJ), PROJ_LD, pp->in[I_BIN] + (size_t)l * WIN_LD};
          pg8::gemm_phase(ldsl, g, S, E); }
        grid.sync();
        { PH_BEGIN
          if (bid < SCAN_BLOCKS) delta_recurrent4(ldsf, bid, WSPTR(bf16_t, WS_PROJ), pp->in[I_CONVW] + (size_t)l * 4 * 1536, WSPTR(float, WS_BETA), WSPTR(float, WS_GLOG), WSPTR(float, WS_MERGED));
          else { const float* relb = pp->in[I_RELB] + l * 4 * 192; const float* sinks = pp->in[I_SINKS] + l * 8;
                 for (int it = bid - SCAN_BLOCKS; it < 1536; it += G - SCAN_BLOCKS) attn_item(lds, it, WSPTR(bf16_t, WS_PROJ), relb, sinks);
                 __syncthreads();
                 pg8::Gemm g{WSPTR(bf16_t, WS_XB), WSPTR(bf16_t, WS_SLOTB + SB_WGATE), M_TOK, 3072, DM, DM, DM}; pg8::StaticOrder S; S.init(M_TOK, 3072, G - SCAN_BLOCKS, bid - SCAN_BLOCKS);
                 pg8::EpiBiasBf16<1, (1 << 30)> E{WSPTR(bf16_t, WS_GATES), 3072, pp->in[I_BGATE] + (size_t)l * 3072};
                 pg8::gemm_phase(ldsl, g, S, E); } }
        grid.sync();
        { PH_BEGIN delta_norm_phase(WSPTR(float, WS_MERGED), WSPTR(bf16_t, WS_PROJ), pp->in[I_GNG] + l * 128); __syncthreads(); }
        grid.sync();
        { PH_BEGIN
          pg8::Gemm g{WSPTR(bf16_t, WS_PROJ), WSPTR(bf16_t, WS_SLOTB + SB_WBR), M_TOK, 3072, 512, PROJ_LD, 512}; pg8::BranchOrder S{G, bid}; pg8::EpiBranch E{WSPTR(bf16_t, WS_GATES), WSPTR(bf16_t, WS_MERGED)};
          pg8::gemm_phase(ldsl, g, S, E); }
        grid.sync();
        { PH_BEGIN
          pg8::Gemm g{WSPTR(bf16_t, WS_MERGED), WSPTR(bf16_t, WS_SLOTB + SB_WOUT), M_TOK, DM, DM, DM, DM}; pg8::StaticOrder S; S.init(M_TOK, DM, G, bid);
          pg8::EpiResid E{(const float*)pp->out, WSPTR(float, WS_YMIX), alpha, 1.0f};
          pg8::gemm_phase(ldsl, g, S, E); }
        grid.sync();
        { PH_BEGIN
          cv_tiles(ldsf, WSPTR(bf16_t, WS_SLOTA), 8192, DM, pp->in[I_FF2IN] + (size_t)l * DM * 8192, 8192, 1, bid, G);
          cv_tiles(ldsf, WSPTR(bf16_t, WS_SLOTB), DM, DFF, pp->in[I_FF2OUT] + (size_t)l * DFF * DM, DM, 0, bid, G);
          ln_phase(ldsf, WSPTR(float, WS_YMIX), pp->in[I_LN2G] + l * DM, pp->in[I_LN2B] + l * DM, pp->out, WSPTR(bf16_t, WS_XB), false, nullptr, nullptr, nullptr, nullptr, nullptr, nullptr); }
        grid.sync();
        { PH_BEGIN
          pg8::Gemm g{WSPTR(bf16_t, WS_XB), WSPTR(bf16_t, WS_SLOTA), M_TOK, 8192, DM, DM, DM}; pg8::StaticOrder S; S.init(M_TOK, 8192, G, bid); pg8::EpiSwiGLU E{WSPTR(bf16_t, WS_H)};
          pg8::gemm_phase(ldsl, g, S, E); }
        grid.sync();
        { PH_BEGIN
          pg8::Gemm g{WSPTR(bf16_t, WS_H), WSPTR(bf16_t, WS_SLOTB), M_TOK, DM, DFF, DFF, DFF}; pg8::StaticOrder S; S.init(M_TOK, DM, G, bid);
          pg8::EpiResid E{(const float*)pp->out, WSPTR(float, WS_YFFN), alpha, 0.5f};
          pg8::gemm_phase(ldsl, g, S, E); }
        grid.sync();
        { PH_BEGIN
          if (l == 0) {
              cv_tiles(ldsf, WSPTR(bf16_t, WS_SLOTA), 8192, DM, pp->in[I_FF1IN] + (size_t)DM * 8192, 8192, 1, bid, G);
              cv_tiles(ldsf, WSPTR(bf16_t, WS_SLOTB), DM, DFF, pp->in[I_FF1OUT] + (size_t)DFF * DM, DM, 0, bid, G);
          }
          ln_phase(ldsf, WSPTR(float, WS_YFFN), pp->in[I_LN3G] + l * DM, pp->in[I_LN3B] + l * DM, pp->out, WSPTR(bf16_t, WS_XB), false, nullptr, nullptr, nullptr, nullptr, nullptr, nullptr); }
        if (l == 0) grid.sync();
}

__global__ void __launch_bounds__(512, 2) fwd_kernel(Params p_unused) {
    extern __shared__ __attribute__((aligned(16))) unsigned char lds[];
    cg::grid_group grid = cg::this_grid();
    const int G0 = gridDim.x, bid0 = blockIdx.x;
    LAS unsigned char* ldsl = (LAS unsigned char*)lds; float* ldsf = (float*)lds;
    const float alpha = 1.41421356237309515f;

    { PH_BEGIN
      cv_tiles(ldsf, WSPTR(bf16_t, WS_SLOTA), 8192, DM, pp->in[I_FF1IN], 8192, 1, bid, G);
      cv_tiles(ldsf, WSPTR(bf16_t, WS_SLOTB), DM, DFF, pp->in[I_FF1OUT], DM, 0, bid, G);
      const float* x = pp->in[I_X]; bf16_t* XB = WSPTR(bf16_t, WS_XB);
      const int tid = threadIdx.x;
      for (size_t i = ((size_t)bid * 512 + tid) * 4; i < (size_t)M_TOK * DM; i += (size_t)G * 512 * 4) {
          const f32x4 v = *(const f32x4*)(x + i); u32x2 w; w.x = cvt_pk_bf16(v[0], v[1]); w.y = cvt_pk_bf16(v[2], v[3]); *(u32x2*)(XB + i) = w; } }
    grid.sync();

    layer_body<0>(grid, G0, bid0, lds, ldsl, ldsf, alpha);
    layer_body<1>(grid, G0, bid0, lds, ldsl, ldsf, alpha);
}


extern "C" void kernel_launch(void* const* d_in, const int* in_sizes, int n_in, void* d_out, int out_size, void* d_ws, size_t ws_size, hipStream_t stream) {
    static int grid_blocks = 0;
    if (!grid_blocks) {
        int dev = 0, cus = 0, per_cu = 0;
        (void)hipGetDevice(&dev);
        (void)hipDeviceGetAttribute(&cus, hipDeviceAttributeMultiprocessorCount, dev);
        if (hipFuncSetAttribute((const void*)fwd_kernel, hipFuncAttributeMaxDynamicSharedMemorySize, LDS_BYTES) != hipSuccess) fprintf(stderr, "kernel_launch: hipFuncSetAttribute failed\n");
        if (hipOccupancyMaxActiveBlocksPerMultiprocessor(&per_cu, (const void*)fwd_kernel, 512, LDS_BYTES) != hipSuccess || per_cu < 1) { fprintf(stderr, "kernel_launch: occupancy query says %d\n", per_cu); per_cu = 1; }
        (void)hipGetLastError();
        grid_blocks = cus * per_cu;
        if (grid_blocks > 256) grid_blocks = 256;
        if (ws_size < WS_END || n_in != 25) fprintf(stderr, "kernel_launch: workspace %zu < %zu or n_in %d != 25\n", ws_size, (size_t)WS_END, n_in);
        fprintf(stderr, "kernel_launch: grid %d (cus %d x %d), ws %zu\n", grid_blocks, cus, per_cu, ws_size);
    }
    Params p{};
    for (int i = 0; i < 25; ++i) p.in[i] = (const float*)d_in[i];
    p.out = (float*)d_out; p.ws = (unsigned char*)d_ws;
    void* args[] = {&p};
    hipError_t e = hipLaunchCooperativeKernel((const void*)fwd_kernel, dim3(grid_blocks), dim3(512), args, LDS_BYTES, stream);
    if (e != hipSuccess) fprintf(stderr, "cooperative launch failed: %s (grid %d)\n", hipGetErrorString(e), grid_blocks);
}
```
